# Optimizing an MI355X kernel written in HIP

```python
import math
import jax, jax.numpy as jnp
from jax import lax
import numpy as np

D_MODEL = 2048
BATCH = 4
SEQ = 2048
DEPTH = 4

CHUNK = 64
N_MIXERS = 3
N_POOL_LAYERS = (DEPTH + 2) // 3
N_SB_LAYERS = (DEPTH + 1) // 3
N_SSM_LAYERS = DEPTH // 3

POOL_WINDOWS = (2, 4, 8, 16)
N_POOL_GROUPS = len(POOL_WINDOWS)
POOL_GROUP_DIM = D_MODEL // N_POOL_GROUPS

SB_HEAD_DIM = 128
SB_HEADS = D_MODEL // SB_HEAD_DIM
Q_BLOCK = 128

SSM_GROUP_CH = 16
SSM_GROUPS = D_MODEL // SSM_GROUP_CH
SSM_STATE = 64
SSM_DT_MIN = 1e-3
SSM_DT_MAX = 1e-1

D_FF = 5632
CONV_WIDTH = 3

RMS_EPS = 1e-6

kernel_name = "hybrid_pool_stickbreak_s5_convffn_trunk"


def rms_norm(x, g):
    xf = x.astype(jnp.float32)
    y = xf * lax.rsqrt(jnp.mean(xf * xf, axis=-1, keepdims=True) + RMS_EPS)
    return (y * g.astype(jnp.float32)).astype(x.dtype)


def multiscale_pool_mixer(h, w, b, scale):
    bsz, seq, _ = h.shape
    hf = h.astype(jnp.float32).reshape(bsz, seq, N_POOL_GROUPS, POOL_GROUP_DIM)
    cs = jnp.cumsum(hf, axis=1)
    cs = jnp.concatenate([jnp.zeros_like(cs[:, :1]), cs], axis=1)
    t = jnp.arange(seq)[:, None]
    win = jnp.array(POOL_WINDOWS, dtype=jnp.int32)[None, :]
    lo = jnp.maximum(t + 1 - win, 0)
    cnt = (t + 1 - lo).astype(jnp.float32)
    grp = jnp.arange(N_POOL_GROUPS)[None, :]
    lower = cs[:, lo, grp]
    mean = (cs[:, 1:] - lower) / cnt[None, :, :, None]
    pooled = mean - hf
    y = jnp.einsum('bsgc,gcd->bsgd', pooled, w.astype(jnp.float32))
    y = y.reshape(bsz, seq, D_MODEL) + b.astype(jnp.float32)
    return (y * scale.astype(jnp.float32)).astype(h.dtype)


def stick_breaking_attention(h, w_qkv, q_gain, k_gain, w_o):
    bsz, seq, _ = h.shape
    qkv = (h @ w_qkv).reshape(bsz, seq, 3, SB_HEADS, SB_HEAD_DIM)
    q = rms_norm(qkv[:, :, 0], q_gain).astype(jnp.float32).transpose(0, 2, 1, 3)
    k = rms_norm(qkv[:, :, 1], k_gain).astype(jnp.float32).transpose(0, 2, 1, 3)
    v = qkv[:, :, 2].transpose(0, 2, 1, 3)
    inv_sqrt_d = 1.0 / math.sqrt(SB_HEAD_DIM)
    outs = []
    for blk in range(seq // Q_BLOCK):
        q0 = blk * Q_BLOCK
        kv_len = q0 + Q_BLOCK
        qb = q[:, :, q0:kv_len]
        kb = k[:, :, :kv_len]
        vb = v[:, :, :kv_len]
        z = jnp.einsum('bhqd,bhkd->bhqk', qb, kb) * inv_sqrt_d
        t_idx = q0 + jnp.arange(Q_BLOCK)[:, None]
        s_idx = jnp.arange(kv_len)[None, :]
        mask = s_idx < t_idx
        log_beta = jax.nn.log_sigmoid(z)
        log_1m_beta = jnp.where(mask, jax.nn.log_sigmoid(-z), 0.0)
        log_remain = lax.cumsum(log_1m_beta, axis=3, reverse=True) - log_1m_beta
        attn = jnp.where(mask, jnp.exp(log_beta + log_remain), 0.0)
        outs.append(jnp.einsum('bhqk,bhkd->bhqd', attn.astype(vb.dtype), vb))
    o = jnp.concatenate(outs, axis=2)
    o = o.transpose(0, 2, 1, 3).reshape(bsz, seq, D_MODEL)
    return o @ w_o


def _ssm_combine(e1, e2):
    a1r, a1i, b1r, b1i = e1
    a2r, a2i, b2r, b2i = e2
    return (a2r * a1r - a2i * a1i,
            a2r * a1i + a2i * a1r,
            a2r * b1r - a2i * b1i + b2r,
            a2r * b1i + a2i * b1r + b2i)


def s5_mixer(h, lam_re, lam_im, log_step, b_re, b_im, c_re, c_im, d_skip, w_glu, b_glu):
    bsz, seq, _ = h.shape
    u = h.astype(jnp.float32).reshape(bsz, seq, SSM_GROUPS, SSM_GROUP_CH)
    lr = lam_re.astype(jnp.float32)
    li = lam_im.astype(jnp.float32)
    step = jnp.exp(log_step.astype(jnp.float32))[:, None]
    mag = jnp.exp(lr * step)
    lb_re = mag * jnp.cos(li * step)
    lb_im = mag * jnp.sin(li * step)
    den = lr * lr + li * li
    f_re = ((lb_re - 1.0) * lr + lb_im * li) / den
    f_im = (lb_im * lr - (lb_re - 1.0) * li) / den
    br = b_re.astype(jnp.float32)
    bi = b_im.astype(jnp.float32)
    bb_re = f_re[..., None] * br - f_im[..., None] * bi
    bb_im = f_re[..., None] * bi + f_im[..., None] * br
    bu_re = jnp.einsum('bsgh,gph->bsgp', u, bb_re)
    bu_im = jnp.einsum('bsgh,gph->bsgp', u, bb_im)
    a_re = jnp.broadcast_to(lb_re, bu_re.shape)
    a_im = jnp.broadcast_to(lb_im, bu_im.shape)
    _, _, xs_re, xs_im = lax.associative_scan(_ssm_combine, (a_re, a_im, bu_re, bu_im), axis=1)
    y = (jnp.einsum('bsgp,ghp->bsgh', xs_re, c_re.astype(jnp.float32))
         - jnp.einsum('bsgp,ghp->bsgh', xs_im, c_im.astype(jnp.float32))
         + d_skip.astype(jnp.float32).reshape(SSM_GROUPS, SSM_GROUP_CH) * u)
    y = jax.nn.gelu(y.reshape(bsz, seq, D_MODEL)).astype(h.dtype)
    gv = y @ w_glu + b_glu
    val, gate = jnp.split(gv, 2, axis=-1)
    return val * jax.nn.sigmoid(gate)


def conv_ffn(h, w_up, conv_w, conv_b, w_down):
    seq = h.shape[1]
    up = h @ w_up
    padded = jnp.pad(up, ((0, 0), (CONV_WIDTH - 1, 0), (0, 0)))
    c = conv_b + sum(conv_w[j] * padded[:, j:j + seq] for j in range(CONV_WIDTH))
    val, gate = jnp.split(c, 2, axis=-1)
    return (jax.nn.silu(gate) * val) @ w_down


def setup_inputs(seed: int = 0) -> dict:
    key = jax.random.key(seed)
    ks = jax.random.split(key, 26)
    f32 = jnp.float32
    nrm = lambda k, shape, s: jax.random.normal(k, shape, f32) * s
    lam_im_base = jnp.pi * jnp.arange(SSM_STATE, dtype=f32)
    return {
        "x": jax.random.normal(ks[0], (BATCH, SEQ, D_MODEL), f32),
        "norm_mix_g": 1.0 + nrm(ks[1], (DEPTH, D_MODEL), 0.02),
        "norm_ffn_g": 1.0 + nrm(ks[2], (DEPTH, D_MODEL), 0.02),
        "pool_w": nrm(ks[3], (N_POOL_LAYERS, N_POOL_GROUPS, POOL_GROUP_DIM, POOL_GROUP_DIM), POOL_GROUP_DIM ** -0.5),
        "pool_b": nrm(ks[4], (N_POOL_LAYERS, D_MODEL), 0.01),
        "pool_scale": 1.0 + nrm(ks[5], (N_POOL_LAYERS, D_MODEL), 0.02),
        "sb_w_qkv": nrm(ks[6], (N_SB_LAYERS, D_MODEL, 3 * D_MODEL), D_MODEL ** -0.5),
        "sb_q_gain": 1.0 + nrm(ks[7], (N_SB_LAYERS, SB_HEAD_DIM), 0.02),
        "sb_k_gain": 1.0 + nrm(ks[8], (N_SB_LAYERS, SB_HEAD_DIM), 0.02),
        "sb_w_o": nrm(ks[9], (N_SB_LAYERS, D_MODEL, D_MODEL), D_MODEL ** -0.5),
        "ssm_lam_re": -0.5 + nrm(ks[10], (N_SSM_LAYERS, SSM_GROUPS, SSM_STATE), 0.01),
        "ssm_lam_im": lam_im_base + nrm(ks[11], (N_SSM_LAYERS, SSM_GROUPS, SSM_STATE), 0.01),
        "ssm_log_step": jax.random.uniform(ks[12], (N_SSM_LAYERS, SSM_GROUPS), f32,
                                           math.log(SSM_DT_MIN), math.log(SSM_DT_MAX)),
        "ssm_b_re": nrm(ks[13], (N_SSM_LAYERS, SSM_GROUPS, SSM_STATE, SSM_GROUP_CH), (2 * SSM_GROUP_CH) ** -0.5),
        "ssm_b_im": nrm(ks[14], (N_SSM_LAYERS, SSM_GROUPS, SSM_STATE, SSM_GROUP_CH), (2 * SSM_GROUP_CH) ** -0.5),
        "ssm_c_re": nrm(ks[15], (N_SSM_LAYERS, SSM_GROUPS, SSM_GROUP_CH, SSM_STATE), (2 * SSM_STATE) ** -0.5),
        "ssm_c_im": nrm(ks[16], (N_SSM_LAYERS, SSM_GROUPS, SSM_GROUP_CH, SSM_STATE), (2 * SSM_STATE) ** -0.5),
        "ssm_d": nrm(ks[17], (N_SSM_LAYERS, D_MODEL), 1.0),
        "ssm_w_glu": nrm(ks[18], (N_SSM_LAYERS, D_MODEL, 2 * D_MODEL), D_MODEL ** -0.5),
        "ssm_b_glu": nrm(ks[19], (N_SSM_LAYERS, 2 * D_MODEL), 0.01),
        "ffn_w_up": nrm(ks[20], (DEPTH, D_MODEL, 2 * D_FF), D_MODEL ** -0.5),
        "ffn_conv_w": nrm(ks[21], (DEPTH, CONV_WIDTH, 2 * D_FF), CONV_WIDTH ** -0.5),
        "ffn_conv_b": nrm(ks[22], (DEPTH, 2 * D_FF), 0.01),
        "ffn_w_down": nrm(ks[23], (DEPTH, D_FF, D_MODEL), D_FF ** -0.5),
    }


def reference(x, norm_mix_g, norm_ffn_g, pool_w, pool_b, pool_scale,
              sb_w_qkv, sb_q_gain, sb_k_gain, sb_w_o,
              ssm_lam_re, ssm_lam_im, ssm_log_step, ssm_b_re, ssm_b_im,
              ssm_c_re, ssm_c_im, ssm_d, ssm_w_glu, ssm_b_glu,
              ffn_w_up, ffn_conv_w, ffn_conv_b, ffn_w_down):
    for i in range(DEPTH):
        kind = i % N_MIXERS
        j = i // N_MIXERS
        h = rms_norm(x, norm_mix_g[i])
        if kind == 0:
            m = multiscale_pool_mixer(h, pool_w[j], pool_b[j], pool_scale[j])
        elif kind == 1:
            m = stick_breaking_attention(h, sb_w_qkv[j], sb_q_gain[j], sb_k_gain[j], sb_w_o[j])
        else:
            m = s5_mixer(h, ssm_lam_re[j], ssm_lam_im[j], ssm_log_step[j], ssm_b_re[j], ssm_b_im[j],
                         ssm_c_re[j], ssm_c_im[j], ssm_d[j], ssm_w_glu[j], ssm_b_glu[j])
        x = x + m
        x = x + conv_ffn(rms_norm(x, norm_ffn_g[i]), ffn_w_up[i], ffn_conv_w[i], ffn_conv_b[i], ffn_w_down[i])
    return x
```

```cpp
#include <hip/hip_runtime.h>
#include <hip/hip_cooperative_groups.h>
#include <cstdio>
#include <cstdint>
namespace cg = cooperative_groups;

#ifndef MK_MULTI
#define MK_MULTI 0
#endif

#define LAS __attribute__((address_space(3)))
typedef unsigned short bf16_t;
typedef short bf16x8 __attribute__((ext_vector_type(8)));
typedef float f32x2 __attribute__((ext_vector_type(2)));
typedef float f32x4 __attribute__((ext_vector_type(4)));
typedef float f32x16 __attribute__((ext_vector_type(16)));
typedef unsigned u32x2 __attribute__((ext_vector_type(2)));
typedef unsigned u32x4 __attribute__((ext_vector_type(4)));
typedef __bf16 bf16x2_t __attribute__((ext_vector_type(2)));

constexpr int DM = 2048, NB = 4, SEQ = 2048, MTOK = NB * SEQ, DFF = 5632, DFF2 = 2 * DFF, DEPTH = 4;
constexpr int NHEAD = 16, HD = 128, SSM_G = 128, SSM_P = 64, SSM_H = 16;
constexpr float RMS_EPS = 1e-6f;
constexpr int NTHR = 512, NWAVE = 8;

constexpr size_t MiB = 1u << 20;
constexpr size_t WS_POOLW = 0;
constexpr size_t WS_QKVW = 4 * MiB;
constexpr size_t WS_OW = 28 * MiB;
constexpr size_t WS_GLUW = 36 * MiB;
constexpr size_t WS_UPW = 52 * MiB;
constexpr size_t WS_DNW = 228 * MiB;
constexpr size_t WS_HN = 320 * MiB;
constexpr size_t WS_MIX = 352 * MiB;
constexpr size_t WS_QK = 384 * MiB;
constexpr size_t WS_VT = 448 * MiB;
constexpr size_t WS_UP = 480 * MiB;
constexpr size_t WS_ACT = 656 * MiB;
constexpr size_t WS_RSQ = 746 * MiB;
constexpr size_t WS_CTL = 744 * MiB;
constexpr size_t WS_END = 762 * MiB;

constexpr int LDS_BYTES = 147456;

__device__ __forceinline__ unsigned pk2(float lo, float hi) { f32x2 v = {lo, hi}; bf16x2_t b = __builtin_convertvector(v, bf16x2_t); return __builtin_bit_cast(unsigned, b); }
__device__ __forceinline__ float bf2f(unsigned short h) { return __uint_as_float(((unsigned)h) << 16); }
__device__ __forceinline__ float bflo(unsigned w) { return __uint_as_float(w << 16); }
__device__ __forceinline__ float bfhi(unsigned w) { return __uint_as_float(w & 0xffff0000u); }
__device__ __forceinline__ float wave_sum(float v) {
#pragma unroll
    for (int o = 1; o < 64; o <<= 1) v += __shfl_xor(v, o);
    return v;
}
__device__ __forceinline__ float rstd_of(float ssq) { return __builtin_amdgcn_rsqf(ssq * (1.0f / DM) + RMS_EPS); }
__device__ __forceinline__ float row_ssq(const float* part, int row, int np4) { const f32x4* p = (const f32x4*)(part + (size_t)row * 64); f32x4 a = p[0];
#pragma unroll 8
    for (int j = 1; j < np4; ++j) a += p[j];
    return (a[0] + a[1]) + (a[2] + a[3]); }
__device__ __forceinline__ float fast_sigmoid(float g) { return __builtin_amdgcn_rcpf(1.0f + __expf(-g)); }

namespace pg8 {
constexpr int BM = 256, BK = 64, HALF = 128, HTB = HALF * BK * 2, STAGE_BYTES = 8 * HTB, NXCD = 8, WGM = 8;
__host__ __device__ __forceinline__ int lds_byte(int r, int c) { const int st = (r >> 4) * 2 + (c >> 5), rr = r & 15, cc = c & 31, ob = rr * 64 + cc * 2; return st * 1024 + (ob ^ (((ob >> 9) & 1) << 5)); }
__host__ __device__ __forceinline__ void stage_rc(int b, int& R, int& C) { const int st = b / 1024, sb = b % 1024, swz = sb ^ (((sb >> 9) & 1) << 5); R = (st >> 1) * 16 + swz / 64; C = (st & 1) * 32 + (swz % 64) / 2; }
__host__ __device__ __forceinline__ int perm32(int rho) { const int n = rho >> 4, i = rho & 15; return 8 * (i >> 2) + 4 * n + (i & 3); }

struct Unit { int pm, pn; int same_pm, same_pn; int seq, next_pn; };
struct Gemm { const bf16_t* A; const bf16_t* Bt; };

struct StaticOrder {
    int nM, nN, nwg, G, c;
    __host__ __device__ __forceinline__ void init(int M, int N, int G_, int c_) { nM = M / BM; nN = N / BM; nwg = nM * nN; G = G_; c = c_; }
    __host__ __device__ __forceinline__ bool next(int i, Unit& u) const {
        const long L = (long)i * G + c; if (L >= nwg) return false;
        int wgid = (int)L; { const int q = nwg / NXCD, r = nwg % NXCD, xcd = wgid % NXCD, off = wgid / NXCD; wgid = (xcd < r ? xcd * (q + 1) : r * (q + 1) + (xcd - r) * q) + off; }
        const int nig = WGM * nN, gid = wgid / nig, fm = gid * WGM, gsz = (nM - fm) < WGM ? (nM - fm) : WGM;
        u.pm = fm + ((wgid % nig) % gsz); u.pn = (wgid % nig) / gsz; return true;
    }
};

template <int MODE> struct EpiBf16 {
    bf16_t* O; int ldc; const float* rsq; int np4; LAS unsigned char* lds;
    __device__ __forceinline__ void operator()(const f32x4 (&acc)[2][2][4][2], const Unit& u, int wr, int wc, int fr, int fq) const {
        const int row0 = u.pm * BM + wr * 64 + fr, col0 = u.pn * BM + wc * 32 + 8 * fq;
        LAS float* ct = (LAS float*)(lds + 131072);
        if (MODE != 0 && !(MODE == 1 ? u.same_pm : u.same_pn)) {
            const int t = (wr * 4 + wc) * 64 + fq * 16 + fr;
            if (t < 256) ct[t] = rstd_of(row_ssq(rsq, (MODE == 1 ? u.pm : u.pn) * BM + t, np4));
            asm volatile("s_waitcnt lgkmcnt(0)\n\ts_barrier" ::: "memory");
        }
        f32x4 cs[2][2];
        if (MODE == 2) {
#pragma unroll
            for (int bj = 0; bj < 2; ++bj)
#pragma unroll
                for (int n = 0; n < 2; ++n) cs[bj][n] = *(const LAS f32x4*)(ct + wc * 32 + 8 * fq + bj * HALF + 4 * n);
        }
#pragma unroll
        for (int ai = 0; ai < 2; ++ai)
#pragma unroll
            for (int m = 0; m < 4; ++m) { const int row = row0 + ai * HALF + m * 16; bf16_t* rowp = O + (size_t)row * ldc + col0;
                float rs = 1.0f; if (MODE == 1) rs = ct[wr * 64 + fr + ai * HALF + m * 16];
#pragma unroll
                for (int bj = 0; bj < 2; ++bj) { f32x4 v0 = acc[ai][bj][m][0], v1 = acc[ai][bj][m][1];
                    if (MODE == 1) { v0 = v0 * rs; v1 = v1 * rs; }
                    if (MODE == 2) { v0 = v0 * cs[bj][0]; v1 = v1 * cs[bj][1]; }
                    u32x4 w; w.x = pk2(v0[0], v0[1]); w.y = pk2(v0[2], v0[3]); w.z = pk2(v1[0], v1[1]); w.w = pk2(v1[2], v1[3]);
                    *(u32x4*)(rowp + bj * HALF) = w; } }
    }
};
template <int MODE> struct EpiResid {
    const float* base; float* out; const float* bias; const float* scale; bf16_t* xb; float* rsq;
    __device__ __forceinline__ void pre(const Unit&, int, int, int, int) {}
    __device__ __forceinline__ void ldgrp(u32x4 (&d)[2][2], size_t off) const {
#pragma unroll
        for (int bj = 0; bj < 2; ++bj) {
            if (MODE == 0) { d[bj][0] = *(const u32x4*)(base + off + bj * HALF); d[bj][1] = *(const u32x4*)(base + off + bj * HALF + 4); }
            else { d[bj][0] = *(const u32x4*)(xb + off + bj * HALF); d[bj][1] = d[bj][0]; } }
    }
    __device__ __forceinline__ void operator()(const f32x4 (&acc)[2][2][4][2], const Unit& u, int wr, int wc, int fr, int fq) const {
        const int row0 = u.pm * BM + wr * 64 + fr, col0 = u.pn * BM + wc * 32 + 8 * fq;
        u32x4 cur[2][2], nxt[2][2], nx2[2][2];
        ldgrp(cur, (size_t)row0 * DM + col0); ldgrp(nxt, (size_t)(row0 + 16) * DM + col0);
#pragma unroll
        for (int j = 0; j < 8; ++j) { const int ai = j >> 2, m = j & 3; const int row = row0 + ai * HALF + m * 16; const size_t off = (size_t)row * DM + col0; float ss = 0.f;
            if (j < 6) ldgrp(nx2, (size_t)(row0 + ((j + 2) >> 2) * HALF + ((j + 2) & 3) * 16) * DM + col0);
#pragma unroll
            for (int bj = 0; bj < 2; ++bj) { f32x4 o[2];
#pragma unroll
                for (int n = 0; n < 2; ++n) { const int cc = bj * HALF + 4 * n;
                    f32x4 v = acc[ai][bj][m][n];
                    if (bias) { v = (v + *(const f32x4*)(bias + col0 + cc)) * *(const f32x4*)(scale + col0 + cc); }
                    f32x4 b;
                    if (MODE == 0) b = __builtin_bit_cast(f32x4, cur[bj][n]);
                    else { const unsigned w0 = n ? cur[bj][0].z : cur[bj][0].x, w1 = n ? cur[bj][0].w : cur[bj][0].y; b = (f32x4){bflo(w0), bfhi(w0), bflo(w1), bfhi(w1)}; }
                    o[n] = b + v;
                    if (MODE == 2) *(f32x4*)(out + off + cc) = o[n];
                    ss += (o[n][0] * o[n][0] + o[n][1] * o[n][1]) + (o[n][2] * o[n][2] + o[n][3] * o[n][3]); }
                if (MODE != 2) { u32x4 w; w.x = pk2(o[0][0], o[0][1]); w.y = pk2(o[0][2], o[0][3]); w.z = pk2(o[1][0], o[1][1]); w.w = pk2(o[1][2], o[1][3]); *(u32x4*)(xb + off + bj * HALF) = w; } }
            if (MODE != 2 && rsq) { ss += __shfl_xor(ss, 16); ss += __shfl_xor(ss, 32); if (fq == 0) rsq[(size_t)row * 64 + u.pn * 4 + wc] = ss; }
#pragma unroll
            for (int bj = 0; bj < 2; ++bj)
#pragma unroll
                for (int n = 0; n < 2; ++n) { cur[bj][n] = nxt[bj][n]; nxt[bj][n] = nx2[bj][n]; }
            asm volatile("" ::: "memory"); }
    }
};
struct EpiGlu {
    const float* bias; bf16_t* xb; float* rsq;
    __device__ __forceinline__ void pre(const Unit&, int, int, int, int) {}
    __device__ __forceinline__ void operator()(const f32x4 (&acc)[2][2][4][2], const Unit& u, int wr, int wc, int fr, int fq) const {
        const int row0 = u.pm * BM + wr * 64 + fr, col0 = u.pn * HALF + wc * 32 + 8 * fq;
        const f32x4 bv0 = *(const f32x4*)(bias + col0), bv1 = *(const f32x4*)(bias + col0 + 4), bg0 = *(const f32x4*)(bias + DM + col0), bg1 = *(const f32x4*)(bias + DM + col0 + 4);
        u32x4 cur = *(const u32x4*)(xb + (size_t)row0 * DM + col0), nxt = cur;
#pragma unroll
        for (int j = 0; j < 8; ++j) { const int ai = j >> 2, m = j & 3; const int row = row0 + ai * HALF + m * 16; const size_t off = (size_t)row * DM + col0; float ss = 0.f; f32x4 o[2];
            if (j < 7) nxt = *(const u32x4*)(xb + (size_t)(row0 + ((j + 1) >> 2) * HALF + ((j + 1) & 3) * 16) * DM + col0);
#pragma unroll
            for (int n = 0; n < 2; ++n) {
                const f32x4 v = acc[ai][0][m][n] + (n ? bv1 : bv0), g = acc[ai][1][m][n] + (n ? bg1 : bg0);
                const unsigned w0 = n ? cur.z : cur.x, w1 = n ? cur.w : cur.y; o[n] = (f32x4){bflo(w0), bfhi(w0), bflo(w1), bfhi(w1)};
                o[n][0] += v[0] * fast_sigmoid(g[0]); o[n][1] += v[1] * fast_sigmoid(g[1]); o[n][2] += v[2] * fast_sigmoid(g[2]); o[n][3] += v[3] * fast_sigmoid(g[3]);
                ss += (o[n][0] * o[n][0] + o[n][1] * o[n][1]) + (o[n][2] * o[n][2] + o[n][3] * o[n][3]); }
            { u32x4 w; w.x = pk2(o[0][0], o[0][1]); w.y = pk2(o[0][2], o[0][3]); w.z = pk2(o[1][0], o[1][1]); w.w = pk2(o[1][2], o[1][3]); *(u32x4*)(xb + off) = w; }
            ss += __shfl_xor(ss, 16); ss += __shfl_xor(ss, 32); if (fq == 0) rsq[(size_t)row * 64 + u.pn * 4 + wc] = ss;
            cur = nxt;
            asm volatile("" ::: "memory"); }
    }
};

struct EpiConv {
    unsigned char* ws; const float* cw; const float* cb; int stage; int np4; LAS unsigned char* lds;
    __device__ __forceinline__ void operator()(const f32x4 (&acc)[2][2][4][2], const Unit& u, int wr, int wc, int fr, int fq) const {
        bf16_t* act = (bf16_t*)(ws + WS_ACT); float* halo = (float*)(ws + WS_UP); const float* rsq = (const float*)(ws + WS_RSQ) + (size_t)stage * MTOK * 64;
        LAS float* ct = (LAS float*)(lds + 131072);
        const int g8 = (wr * 16 + fr) * 8, f0 = u.pn * HALF + wc * 32 + 8 * fq, pc0 = u.pn * BM + wc * 32 + 8 * fq;
        LAS float* wt = (LAS float*)(lds + 132096);
        f32x4 pw[8], pw2[8];
        if (u.seq == 0) {
            pw[0] = *(const f32x4*)(cw + f0); pw[1] = *(const f32x4*)(cw + DFF2 + f0); pw[2] = *(const f32x4*)(cw + 2 * DFF2 + f0); pw[3] = *(const f32x4*)(cb + f0);
            pw[4] = *(const f32x4*)(cw + DFF + f0); pw[5] = *(const f32x4*)(cw + DFF2 + DFF + f0); pw[6] = *(const f32x4*)(cw + 2 * DFF2 + DFF + f0); pw[7] = *(const f32x4*)(cb + DFF + f0);
            pw2[0] = *(const f32x4*)(cw + f0 + 4); pw2[1] = *(const f32x4*)(cw + DFF2 + f0 + 4); pw2[2] = *(const f32x4*)(cw + 2 * DFF2 + f0 + 4); pw2[3] = *(const f32x4*)(cb + f0 + 4);
            pw2[4] = *(const f32x4*)(cw + DFF + f0 + 4); pw2[5] = *(const f32x4*)(cw + DFF2 + DFF + f0 + 4); pw2[6] = *(const f32x4*)(cw + 2 * DFF2 + DFF + f0 + 4); pw2[7] = *(const f32x4*)(cb + DFF + f0 + 4);
        } else {
            const LAS float* wsrc = wt + (u.seq & 1) * 1024 + wc * 32 + 8 * fq;
#pragma unroll
            for (int a = 0; a < 8; ++a) { pw[a] = *(const LAS f32x4*)(wsrc + a * 128); pw2[a] = *(const LAS f32x4*)(wsrc + a * 128 + 4); }
        }
        if (u.next_pn >= 0 && wr == 0) {
            const int lane_ = fq * 16 + fr;
            const float* p0 = (wc == 0) ? cw : (wc == 1) ? cw + 2 * DFF2 : (wc == 2) ? cw + DFF : cw + 2 * DFF2 + DFF;
            const float* p1 = (wc == 0) ? cw + DFF2 : (wc == 1) ? cb : (wc == 2) ? cw + DFF2 + DFF : cb + DFF;
            const float* src = ((lane_ >> 5) ? p1 : p0) + u.next_pn * HALF + (lane_ & 31) * 4;
            __builtin_amdgcn_global_load_lds((const unsigned*)src, (LAS unsigned*)(lds + 132096 + ((u.seq + 1) & 1) * 4096 + wc * 1024), 16, 0, 0);
        }
        if (!u.same_pm) { const int t = (wr * 4 + wc) * 64 + fq * 16 + fr;
          if (t < 256) ct[t] = rstd_of(row_ssq(rsq, u.pm * BM + t, np4));
          asm volatile("s_waitcnt lgkmcnt(0)\n\ts_barrier" ::: "memory"); }
        float rs[8];
        { const f32x4 r0 = *(const LAS f32x4*)(ct + g8), r1 = *(const LAS f32x4*)(ct + g8 + 4);
#pragma unroll
          for (int e = 0; e < 4; ++e) { rs[e] = r0[e]; rs[4 + e] = r1[e]; } }
        float* hrow = halo + (size_t)((u.pm * 2 + wr) * 4) * DFF2 + pc0;
        bf16_t* arow = act + (size_t)(u.pm * BM + g8) * DFF + f0;
#pragma unroll
        for (int n = 0; n < 2; ++n) {
            const int f = f0 + 4 * n;
            f32x4 wv0, wv1, wv2, bvv, wg0, wg1, wg2, bgg;
            if (n == 0) { wv0 = pw[0]; wv1 = pw[1]; wv2 = pw[2]; bvv = pw[3]; wg0 = pw[4]; wg1 = pw[5]; wg2 = pw[6]; bgg = pw[7]; }
            else { wv0 = pw2[0]; wv1 = pw2[1]; wv2 = pw2[2]; bvv = pw2[3]; wg0 = pw2[4]; wg1 = pw2[5]; wg2 = pw2[6]; bgg = pw2[7]; }
            const f32x4 v6 = acc[1][0][2][n] * rs[6], v7 = acc[1][0][3][n] * rs[7], g6 = acc[1][1][2][n] * rs[6], g7 = acc[1][1][3][n] * rs[7];
            f32x4 av2, av1, ag2, ag1;
#pragma unroll
            for (int e = 0; e < 4; ++e) { av2[e] = __shfl_up(v6[e], 1, 16); av1[e] = __shfl_up(v7[e], 1, 16); ag2[e] = __shfl_up(g6[e], 1, 16); ag1[e] = __shfl_up(g7[e], 1, 16); }
            if (fr == 15) { *(f32x4*)(hrow + 2 * DFF2 + 4 * n) = v6; *(f32x4*)(hrow + 2 * DFF2 + HALF + 4 * n) = g6; *(f32x4*)(hrow + 3 * DFF2 + 4 * n) = v7; *(f32x4*)(hrow + 3 * DFF2 + HALF + 4 * n) = g7; }
#pragma unroll
            for (int j = 0; j < 8; ++j) {
                const f32x4 cv_ = acc[j >> 2][0][j & 3][n] * rs[j], cg_ = acc[j >> 2][1][j & 3][n] * rs[j];
                if (j < 2 && fr == 0) { *(f32x4*)(hrow + j * DFF2 + 4 * n) = cv_; *(f32x4*)(hrow + j * DFF2 + HALF + 4 * n) = cg_; }
                const f32x4 cv = bvv + wv0 * av2 + wv1 * av1 + wv2 * cv_, cg = bgg + wg0 * ag2 + wg1 * ag1 + wg2 * cg_;
                f32x4 o;
#pragma unroll
                for (int e = 0; e < 4; ++e) o[e] = cg[e] * fast_sigmoid(cg[e]) * cv[e];
                u32x2 w; w.x = pk2(o[0], o[1]); w.y = pk2(o[2], o[3]);
                if (!(j < 2 && fr == 0)) *(u32x2*)(arow + (size_t)j * DFF + 4 * n) = w;
                av2 = av1; av1 = cv_; ag2 = ag1; ag1 = cg_;
            }
        }
    }
};

template <int K, int LDA, int LDB, int KGRP, bool APERM, class Epi>
__device__ __forceinline__ void gemm_phase(LAS unsigned char* lds, const Gemm g, const StaticOrder& S, const Epi& E, const int tid) {
    const int wid = __builtin_amdgcn_readfirstlane(tid >> 6), lane = tid & 63, wr = wid >> 2, wc = wid & 3, fr = lane & 15, fq = lane >> 4;
    constexpr int nt = K / BK;
    unsigned voffA[2], voffB[2];
#pragma unroll
    for (int i = 0; i < 2; ++i) { int R, C; stage_rc(tid * 16 + i * 8192, R, C); const int Rb = (R & ~31) + perm32(R & 31);
        const int Ra = APERM ? (((R >> 6) * 16 + (R & 15)) * 8 + ((R >> 4) & 3)) : R;
        voffA[i] = (unsigned)(Ra * LDA + C) * 2u; voffB[i] = (unsigned)(Rb * LDB + C) * 2u; }
    constexpr size_t kstep = (size_t)(BK * 2);
    constexpr size_t hstepA = APERM ? (size_t)4 * LDA * 2 : (size_t)HALF * LDA * 2, hstepB = (size_t)HALF * LDB * 2;
    constexpr size_t tstepA = (size_t)BM * LDA * 2, tstepB = 2 * hstepB;
    const unsigned ldsw = (unsigned)wid * 1024u;
    const int aoff = lds_byte(wr * 64 + fr, fq * 8), boff = lds_byte(wc * 32 + fr, fq * 8);
#define PG8_SA(b, h) (((b) * 2 + (h)) * HTB)
#define PG8_SB(b, h) ((4 + (b) * 2 + (h)) * HTB)
#define PG8_STAGE(bufoff, gbase, voff) do { _Pragma("unroll") for (int _i = 0; _i < 2; ++_i) \
        __builtin_amdgcn_global_load_lds((const unsigned*)((const char*)(gbase) + (voff)[_i]), (LAS unsigned*)(lds + (bufoff) + ldsw + _i * 8192), 16, 0, 0); } while (0)
#define PG8_LDA(dst, b, h) do { _Pragma("unroll") for (int m = 0; m < 4; ++m) _Pragma("unroll") for (int k = 0; k < 2; ++k) dst[m][k] = *(const LAS bf16x8*)(lds + PG8_SA(b, h) + aoff + m * 2048 + k * 1024); } while (0)
#define PG8_LDB(dst, b, h) do { _Pragma("unroll") for (int n = 0; n < 2; ++n) _Pragma("unroll") for (int k = 0; k < 2; ++k) dst[n][k] = *(const LAS bf16x8*)(lds + PG8_SB(b, h) + boff + n * 2048 + k * 1024); } while (0)
#define PG8_MMA(ai, bj, At, Bt) do { __builtin_amdgcn_s_setprio(1); _Pragma("unroll") for (int m = 0; m < 4; ++m) _Pragma("unroll") for (int n = 0; n < 2; ++n) _Pragma("unroll") for (int k = 0; k < 2; ++k) \
        acc[ai][bj][m][n] = __builtin_amdgcn_mfma_f32_16x16x32_bf16(Bt[n][k], At[m][k], acc[ai][bj][m][n], 0, 0, 0); __builtin_amdgcn_s_setprio(0); } while (0)
#define PG8_WAIT_V(n) asm volatile("s_waitcnt vmcnt(" #n ")" ::: "memory")
#define PG8_WAIT_L(n) asm volatile("s_waitcnt lgkmcnt(" #n ")" ::: "memory")
#define PG8_BAR __builtin_amdgcn_s_barrier()
#define PG8_SCHED __builtin_amdgcn_sched_barrier(0)
#define PG8_UA(u) ((const char*)g.A + (size_t)(u).pm * tstepA + (KGRP ? (size_t)((u).pn / (KGRP ? KGRP : 1)) * (size_t)K * 2 : (size_t)0))
#define PG8_UB(u) ((const char*)g.Bt + (size_t)(u).pn * tstepB)
    Unit cur, nxt; int ui = 0;
    if (!S.next(0, cur)) return;
    cur.same_pm = 0; cur.same_pn = 0; cur.seq = 0; cur.next_pn = -1;
    f32x4 acc[2][2][4][2];
#pragma unroll
    for (int a = 0; a < 2; ++a)
#pragma unroll
        for (int b = 0; b < 2; ++b)
#pragma unroll
            for (int m = 0; m < 4; ++m)
#pragma unroll
                for (int n = 0; n < 2; ++n) acc[a][b][m][n] = (f32x4){0.f, 0.f, 0.f, 0.f};
    bf16x8 At[4][2], B0[2][2], B1[2][2];
    const char* cA = PG8_UA(cur); const char* cB = PG8_UB(cur);
    PG8_STAGE(PG8_SB(0, 0), cB, voffB); PG8_STAGE(PG8_SB(0, 1), cB + hstepB, voffB); PG8_STAGE(PG8_SA(0, 0), cA, voffA); PG8_STAGE(PG8_SA(0, 1), cA + hstepA, voffA);
    if (wr == 1) PG8_BAR;
    PG8_WAIT_V(2); PG8_BAR;
    PG8_STAGE(PG8_SB(1, 0), cB + kstep, voffB); PG8_STAGE(PG8_SA(1, 0), cA + kstep, voffA); PG8_STAGE(PG8_SB(1, 1), cB + hstepB + kstep, voffB);
    PG8_WAIT_V(6); PG8_BAR;
    for (;;) {
        const bool has_next = S.next(ui + 1, nxt);
        nxt.same_pm = (has_next && nxt.pm == cur.pm) ? 1 : 0; nxt.same_pn = (has_next && nxt.pn == cur.pn) ? 1 : 0; nxt.seq = ui + 1; nxt.next_pn = -1; cur.next_pn = has_next ? nxt.pn : -1;
        const char* nA = has_next ? PG8_UA(nxt) : cA; const char* nB = has_next ? PG8_UB(nxt) : cB;
        for (int t = 0; t < nt; t += 2) {
            const bool last = (t == nt - 2);
            const char* a1 = cA + (size_t)(t + 1) * kstep;
            const char* a2 = last ? nA : cA + (size_t)(t + 2) * kstep; const char* b2 = last ? nB : cB + (size_t)(t + 2) * kstep;
            const char* a3 = a2 + kstep; const char* b3 = b2 + kstep;
            PG8_LDB(B0, 0, 0); PG8_LDB(B1, 0, 1); PG8_SCHED; PG8_LDA(At, 0, 0); PG8_STAGE(PG8_SA(1, 1), a1 + hstepA, voffA);
            PG8_WAIT_V(8); PG8_WAIT_L(0); PG8_BAR; PG8_MMA(0, 0, At, B0); PG8_MMA(0, 1, At, B1); PG8_BAR; PG8_SCHED;
            PG8_LDA(At, 0, 1); PG8_STAGE(PG8_SB(0, 0), b2, voffB); PG8_STAGE(PG8_SB(0, 1), b2 + hstepB, voffB); PG8_STAGE(PG8_SA(0, 0), a2, voffA);
            PG8_WAIT_V(8); PG8_WAIT_L(0); PG8_BAR; PG8_MMA(1, 0, At, B0); PG8_MMA(1, 1, At, B1); PG8_BAR; PG8_SCHED;
            PG8_LDB(B0, 1, 0); PG8_LDB(B1, 1, 1); PG8_SCHED; PG8_LDA(At, 1, 0); PG8_STAGE(PG8_SA(0, 1), a2 + hstepA, voffA);
            PG8_WAIT_V(8); PG8_WAIT_L(0); PG8_BAR; PG8_MMA(0, 0, At, B0); PG8_MMA(0, 1, At, B1); PG8_BAR; PG8_SCHED;
            PG8_LDA(At, 1, 1); PG8_STAGE(PG8_SB(1, 0), b3, voffB); PG8_STAGE(PG8_SB(1, 1), b3 + hstepB, voffB); PG8_STAGE(PG8_SA(1, 0), a3, voffA);
            PG8_WAIT_V(8); PG8_WAIT_L(0); PG8_BAR; PG8_MMA(1, 0, At, B0); PG8_MMA(1, 1, At, B1); PG8_BAR; PG8_SCHED;
        }
        if (wr == 0) PG8_BAR;
        E(acc, cur, wr, wc, fr, fq);
        if (!has_next) break;
#pragma unroll
        for (int a = 0; a < 2; ++a)
#pragma unroll
            for (int b = 0; b < 2; ++b)
#pragma unroll
                for (int m = 0; m < 4; ++m)
#pragma unroll
                    for (int n = 0; n < 2; ++n) acc[a][b][m][n] = (f32x4){0.f, 0.f, 0.f, 0.f};
        cur = nxt; cA = nA; cB = nB; ++ui;
        if (wr == 1) PG8_BAR;
    }
    PG8_WAIT_V(0);
    PG8_BAR;
#undef PG8_SA
#undef PG8_SB
#undef PG8_STAGE
#undef PG8_LDA
#undef PG8_LDB
#undef PG8_MMA
#undef PG8_WAIT_V
#undef PG8_WAIT_L
#undef PG8_BAR
#undef PG8_SCHED
#undef PG8_UA
#undef PG8_UB
}
}

__device__ __forceinline__ void tr_item(const float* __restrict__ W, int K, int N, bf16_t* __restrict__ WT, int k0, int n0, int drow0, const float* gain, LAS float* scr, int lane) {
    f32x4 v[16];
    const int kq_ = lane >> 4, nn = (lane & 15) * 4;
#pragma unroll
    for (int i = 0; i < 16; ++i) v[i] = __builtin_nontemporal_load((const f32x4*)(W + (size_t)(k0 + 4 * i + kq_) * N + n0 + nn));
#pragma unroll
    for (int i = 0; i < 16; ++i) { const int kk = 4 * i + kq_; f32x4 t = v[i];
        if (gain) t = t * gain[k0 + kk];
        LAS float* s = scr + kk * 65 + nn; s[0] = t[0]; s[1] = t[1]; s[2] = t[2]; s[3] = t[3]; }
    asm volatile("s_waitcnt lgkmcnt(0)" ::: "memory");
    const int c = lane & 7;
#pragma unroll
    for (int j = 0; j < 8; ++j) { const int n = (lane >> 3) + 8 * j; const LAS float* s = scr + (8 * c) * 65 + n;
        u32x4 o; o.x = pk2(s[0 * 65], s[1 * 65]); o.y = pk2(s[2 * 65], s[3 * 65]); o.z = pk2(s[4 * 65], s[5 * 65]); o.w = pk2(s[6 * 65], s[7 * 65]);
        *(u32x4*)(WT + (size_t)(drow0 + n) * K + k0 + 8 * c) = o; }
    asm volatile("s_waitcnt lgkmcnt(0)" ::: "memory");
}
__device__ __forceinline__ int pair_row(int n0, int H) { const int gsel = n0 >= H ? 1 : 0, nn = n0 - gsel * H; return (nn >> 7) * 256 + gsel * 128 + (nn & 127); }
__device__ __forceinline__ bool tr_matrix(int& it, const float* W, int K, int N, bf16_t* WT, int drow_base, int pairH, const float* gain, LAS float* scr, int lane) {
    const int nb = N / 64, cnt = (K / 64) * nb;
    if (it >= cnt) { it -= cnt; return false; }
    const int kb = it / nb, n0 = (it % nb) * 64;
    tr_item(W, K, N, WT, kb * 64, n0, drow_base + (pairH ? pair_row(n0, pairH) : n0), gain, scr, lane);
    return true;
}

__device__ __forceinline__ void norm_row(const float* __restrict__ xrow, const float* __restrict__ g, bf16_t* __restrict__ orow, int lane) {
    f32x4 v[8]; float s = 0.f;
#pragma unroll
    for (int j = 0; j < 8; ++j) { v[j] = ((const f32x4*)xrow)[lane + 64 * j]; s += (v[j][0] * v[j][0] + v[j][1] * v[j][1]) + (v[j][2] * v[j][2] + v[j][3] * v[j][3]); }
    const float rstd = 1.0f / sqrtf(wave_sum(s) * (1.0f / DM) + RMS_EPS);
#pragma unroll
    for (int j = 0; j < 8; ++j) { const f32x4 gv = ((const f32x4*)g)[lane + 64 * j]; const f32x4 o = v[j] * rstd * gv;
        u32x2 w; w.x = pk2(o[0], o[1]); w.y = pk2(o[2], o[3]); ((u32x2*)orow)[lane + 64 * j] = w; }
}
__device__ __forceinline__ void norm_phase(const float* x, const float* g, bf16_t* hn, int gw, int ngw, int lane) {
    for (int m = gw; m < MTOK; m += ngw) norm_row(x + (size_t)m * DM, g, hn + (size_t)m * DM, lane);
}

__device__ __forceinline__ f32x4 ldx4(const float* x, const bf16_t* x16, size_t idx) {
    if (x16) { const u32x2 w = *(const u32x2*)(x16 + idx); return (f32x4){bflo(w.x), bfhi(w.x), bflo(w.y), bfhi(w.y)}; }
    return *(const f32x4*)(x + idx);
}
__device__ __forceinline__ void pool_phase(const float* __restrict__ x, const bf16_t* __restrict__ x16, const float* __restrict__ g, const float* rsq, bf16_t* __restrict__ pooled, LAS unsigned char* lds, int tid, int wid, int lane, int bid) {
    LAS float* rs = (LAS float*)lds;
    for (int chunk = bid; chunk < MTOK / 32; chunk += gridDim.x) {
        const int t0 = chunk * 32, bstart = (t0 / SEQ) * SEQ;
        for (int i = wid; i < 47; i += NWAVE) { const int r = t0 - 15 + i; float val = 0.f;
            if (r >= bstart && rsq) val = rstd_of(wave_sum(lane < 32 ? rsq[(size_t)r * 64 + lane] : 0.f));
            else if (r >= bstart) { float s = 0.f; const f32x4* xr = (const f32x4*)(x + (size_t)r * DM);
#pragma unroll
                for (int j = 0; j < 8; ++j) { const f32x4 v = xr[lane + 64 * j]; s += (v[0] * v[0] + v[1] * v[1]) + (v[2] * v[2] + v[3] * v[3]); }
                val = 1.0f / sqrtf(wave_sum(s) * (1.0f / DM) + RMS_EPS); }
            if (lane == 0) rs[i] = val; }
        __syncthreads();
        const int c = tid * 4, w = 2 << (c >> 9);
        const f32x4 gv = *(const f32x4*)(g + c);
        f32x4 S = {0.f, 0.f, 0.f, 0.f};
        for (int j = 1; j < w; ++j) { const int r = t0 - j; if (r >= bstart) S += ldx4(x, x16, (size_t)r * DM + c) * rs[15 - j]; }
        for (int tt = 0; tt < 32; ++tt) { const int r = t0 + tt;
            const f32x4 h = ldx4(x, x16, (size_t)r * DM + c) * rs[15 + tt];
            S += h;
            const int tin = r - bstart; const float inv = 1.0f / (float)(tin + 1 < w ? tin + 1 : w);
            const f32x4 p = (S * inv - h) * gv;
            u32x2 o; o.x = pk2(p[0], p[1]); o.y = pk2(p[2], p[3]); *(u32x2*)(pooled + (size_t)r * DM + c) = o;
            const int ro = r - w + 1; if (ro >= bstart) S -= ldx4(x, x16, (size_t)ro * DM + c) * rs[ro - (t0 - 15)]; }
        __syncthreads();
    }
}

__device__ __forceinline__ void convfix_phase(const float* __restrict__ halo, const float* __restrict__ cw, const float* __restrict__ cb, bf16_t* __restrict__ act, int gtid, int ngt) {
    constexpr int NQ = DFF / 4, NCHUNK = MTOK / 128;
    for (int item = gtid; item < NCHUNK * 2 * NQ; item += ngt) {
        const int c = item / (2 * NQ), r = (item / NQ) & 1, f = (item % NQ) * 4, vcol = (f >> 7) * 256 + (f & 127);
        const bool first = ((c * 128) % SEQ) == 0;
        const float* hc = halo + (size_t)(c * 4) * DFF2 + vcol; const float* hp = hc - (size_t)4 * DFF2;
        const f32x4 z = {0.f, 0.f, 0.f, 0.f};
        const f32x4 v0 = *(const f32x4*)(hc + (size_t)r * DFF2), g0 = *(const f32x4*)(hc + (size_t)r * DFF2 + 128);
        f32x4 v1, g1, v2, g2;
        if (r == 1) { v1 = *(const f32x4*)(hc); g1 = *(const f32x4*)(hc + 128); if (first) { v2 = z; g2 = z; } else { v2 = *(const f32x4*)(hp + (size_t)3 * DFF2); g2 = *(const f32x4*)(hp + (size_t)3 * DFF2 + 128); } }
        else if (first) { v1 = z; g1 = z; v2 = z; g2 = z; }
        else { v1 = *(const f32x4*)(hp + (size_t)3 * DFF2); g1 = *(const f32x4*)(hp + (size_t)3 * DFF2 + 128); v2 = *(const f32x4*)(hp + (size_t)2 * DFF2); g2 = *(const f32x4*)(hp + (size_t)2 * DFF2 + 128); }
        const f32x4 cv = *(const f32x4*)(cb + f) + *(const f32x4*)(cw + f) * v2 + *(const f32x4*)(cw + DFF2 + f) * v1 + *(const f32x4*)(cw + 2 * DFF2 + f) * v0;
        const f32x4 cg = *(const f32x4*)(cb + DFF + f) + *(const f32x4*)(cw + DFF + f) * g2 + *(const f32x4*)(cw + DFF2 + DFF + f) * g1 + *(const f32x4*)(cw + 2 * DFF2 + DFF + f) * g0;
        u32x2 w; w.x = pk2(cg[0] * fast_sigmoid(cg[0]) * cv[0], cg[1] * fast_sigmoid(cg[1]) * cv[1]); w.y = pk2(cg[2] * fast_sigmoid(cg[2]) * cv[2], cg[3] * fast_sigmoid(cg[3]) * cv[3]);
        *(u32x2*)(act + (size_t)(c * 128 + r) * DFF + f) = w;
    }
}

__device__ __forceinline__ void convfix_tile(const float* __restrict__ halo, const float* __restrict__ cw, const float* __restrict__ cb, bf16_t* __restrict__ act, int pm, int tid) {
    constexpr int NQ = DFF / 4;
    const int cA = 2 * pm; const bool first = ((cA * 128) % SEQ) == 0;
    for (int q = tid; q < NQ; q += NTHR) {
        const int f = q * 4, vcol = (f >> 7) * 256 + (f & 127);
        const float* hA = halo + (size_t)(cA * 4) * DFF2 + vcol; const float* hP = first ? hA : hA - (size_t)4 * DFF2; const float* hB = hA + (size_t)4 * DFF2;
        f32x4 c[2][4];
#pragma unroll
        for (int part = 0; part < 2; ++part) {
            const int po = part * DFF, ho = part * 128;
            const f32x4 w0 = *(const f32x4*)(cw + po + f), w1 = *(const f32x4*)(cw + DFF2 + po + f), w2 = *(const f32x4*)(cw + 2 * DFF2 + po + f), bb = *(const f32x4*)(cb + po + f);
            f32x4 u[8];
#pragma unroll
            for (int k = 0; k < 2; ++k) {
                u[k] = *(const f32x4*)(hP + (size_t)(2 + k) * DFF2 + ho); u[2 + k] = *(const f32x4*)(hA + (size_t)k * DFF2 + ho);
                u[4 + k] = *(const f32x4*)(hA + (size_t)(2 + k) * DFF2 + ho); u[6 + k] = *(const f32x4*)(hB + (size_t)k * DFF2 + ho); }
            if (first) { const f32x4 z = {0.f, 0.f, 0.f, 0.f}; u[0] = z; u[1] = z; }
#pragma unroll
            for (int o = 0; o < 4; ++o) { const int i = (o < 2) ? 2 + o : 4 + o; c[part][o] = bb + w0 * u[i - 2] + w1 * u[i - 1] + w2 * u[i]; }
        }
#pragma unroll
        for (int o = 0; o < 4; ++o) { const f32x4 cv = c[0][o], cg = c[1][o];
            u32x2 w; w.x = pk2(cg[0] * fast_sigmoid(cg[0]) * cv[0], cg[1] * fast_sigmoid(cg[1]) * cv[1]); w.y = pk2(cg[2] * fast_sigmoid(cg[2]) * cv[2], cg[3] * fast_sigmoid(cg[3]) * cv[3]);
            *(u32x2*)(act + (size_t)((cA + (o >> 1)) * 128 + (o & 1)) * DFF + f) = w; }
    }
}

__device__ __forceinline__ void qknorm_phase(bf16_t* __restrict__ qk, const float* __restrict__ qg, const float* __restrict__ kg, int gw, int ngw, int lane) {
    const float QS = 1.4426950408889634f * 0.08838834764831845f;
    for (int it = gw; it < MTOK * 2; it += ngw) {
        const int row = it >> 1, part = it & 1;
        bf16_t* p = qk + (size_t)row * 4096 + part * 2048;
        const float* gg = part ? kg : qg; const float sc = part ? 1.0f : QS;
#pragma unroll
        for (int j = 0; j < 4; ++j) {
            const int c = lane + 64 * j;
            const u32x4 w = *(const u32x4*)(p + c * 8);
            float v[8];
#pragma unroll
            for (int q = 0; q < 4; ++q) { v[2 * q] = bflo(w[q]); v[2 * q + 1] = bfhi(w[q]); }
            float s = 0.f;
#pragma unroll
            for (int e = 0; e < 8; ++e) s += v[e] * v[e];
            s += __shfl_xor(s, 1); s += __shfl_xor(s, 2); s += __shfl_xor(s, 4); s += __shfl_xor(s, 8);
            const float rstd = sc / sqrtf(s * (1.0f / HD) + RMS_EPS);
            const int d0 = (c & 15) * 8;
            const f32x4 ga = *(const f32x4*)(gg + d0), gb = *(const f32x4*)(gg + d0 + 4);
            u32x4 o; o.x = pk2(v[0] * rstd * ga[0], v[1] * rstd * ga[1]); o.y = pk2(v[2] * rstd * ga[2], v[3] * rstd * ga[3]);
            o.z = pk2(v[4] * rstd * gb[0], v[5] * rstd * gb[1]); o.w = pk2(v[6] * rstd * gb[2], v[7] * rstd * gb[3]);
            *(u32x4*)(p + c * 8) = o;
        }
    }
}

constexpr int AK_ROWB = 272, AV_ROWB = 144, AK_BUF = 64 * AK_ROWB, AV_BUF = 128 * AV_ROWB;
constexpr float ATT_DONE_LOG2 = 60.0f;
__device__ __forceinline__ u32x4 knorm8(u32x4 w, const f32x4 ga, const f32x4 gb) {
    float v[8];
#pragma unroll
    for (int q = 0; q < 4; ++q) { v[2 * q] = bflo(w[q]); v[2 * q + 1] = bfhi(w[q]); }
    float ss = 0.f;
#pragma unroll
    for (int e = 0; e < 8; ++e) ss += v[e] * v[e];
    ss += __shfl_xor(ss, 1); ss += __shfl_xor(ss, 2); ss += __shfl_xor(ss, 4); ss += __shfl_xor(ss, 8);
    const float r = __builtin_amdgcn_rsqf(ss * (1.0f / HD) + RMS_EPS);
    u32x4 o; o.x = pk2(v[0] * r * ga[0], v[1] * r * ga[1]); o.y = pk2(v[2] * r * ga[2], v[3] * r * ga[3]); o.z = pk2(v[4] * r * gb[0], v[5] * r * gb[1]); o.w = pk2(v[6] * r * gb[2], v[7] * r * gb[3]);
    return o;
}
__device__ __forceinline__ void attn_unit(int b, int h, int qb, const bf16_t* __restrict__ QK, const bf16_t* __restrict__ VT, bf16_t* __restrict__ O, const float* __restrict__ qg, const float* __restrict__ kg,
                                          LAS unsigned char* lds, int tid, int wid, int lane) {
    const int r32 = lane & 31, hi = lane >> 5;
    const int q0 = qb * 256, NT = (q0 + 256) / 64;
    LAS unsigned char* Kb = lds; LAS unsigned char* Vb = lds + 2 * AK_BUF;
    LAS unsigned* flags = (LAS unsigned*)(lds + 2 * AK_BUF + 2 * AV_BUF);
    const int kc0 = tid, kc1 = tid + 512;
    const bf16_t* kg0 = QK + (size_t)(b * SEQ + (kc0 >> 4)) * 4096 + 2048 + h * HD + (kc0 & 15) * 8;
    const bf16_t* kg1 = QK + (size_t)(b * SEQ + (kc1 >> 4)) * 4096 + 2048 + h * HD + (kc1 & 15) * 8;
    const bf16_t* vg0 = VT + (size_t)(h * HD + (kc0 >> 3)) * MTOK + b * SEQ + (kc0 & 7) * 8;
    const bf16_t* vg1 = VT + (size_t)(h * HD + (kc1 >> 3)) * MTOK + b * SEQ + (kc1 & 7) * 8;
    const int kl0 = (kc0 >> 4) * AK_ROWB + (kc0 & 15) * 16, kl1 = (kc1 >> 4) * AK_ROWB + (kc1 & 15) * 16;
    const int vl0 = (kc0 >> 3) * AV_ROWB + (kc0 & 7) * 16, vl1 = (kc1 >> 3) * AV_ROWB + (kc1 & 7) * 16;
    const f32x4 kga = *(const f32x4*)(kg + (tid & 15) * 8), kgb = *(const f32x4*)(kg + (tid & 15) * 8 + 4);
    const int tq = q0 + wid * 32 + r32;
    bf16x8 qr[8];
    { const bf16_t* qp = QK + (size_t)(b * SEQ + tq) * 4096 + h * HD + hi * 8;
      u32x4 raw[8]; float ss = 0.f;
#pragma unroll
      for (int ks = 0; ks < 8; ++ks) { raw[ks] = *(const u32x4*)(qp + ks * 16);
#pragma unroll
          for (int q = 0; q < 4; ++q) { const float a = bflo(raw[ks][q]), c = bfhi(raw[ks][q]); ss += a * a + c * c; } }
      ss += __shfl_xor(ss, 32);
      const float r = __builtin_amdgcn_rsqf(ss * (1.0f / HD) + RMS_EPS) * (1.4426950408889634f * 0.08838834764831845f);
#pragma unroll
      for (int ks = 0; ks < 8; ++ks) { const f32x4 ga = *(const f32x4*)(qg + ks * 16 + hi * 8), gb = *(const f32x4*)(qg + ks * 16 + hi * 8 + 4); u32x4 o;
          o.x = pk2(bflo(raw[ks][0]) * r * ga[0], bfhi(raw[ks][0]) * r * ga[1]); o.y = pk2(bflo(raw[ks][1]) * r * ga[2], bfhi(raw[ks][1]) * r * ga[3]);
          o.z = pk2(bflo(raw[ks][2]) * r * gb[0], bfhi(raw[ks][2]) * r * gb[1]); o.w = pk2(bflo(raw[ks][3]) * r * gb[2], bfhi(raw[ks][3]) * r * gb[3]);
          qr[ks] = __builtin_bit_cast(bf16x8, o); } }
    const int krow = 16 * ((r32 >> 2) & 1) + (r32 & 3) + 4 * (r32 >> 3);
    const int kfo = krow * AK_ROWB + hi * 16, vfo = r32 * AV_ROWB + hi * 32;
    f32x16 o[4];
#pragma unroll
    for (int d = 0; d < 4; ++d)
#pragma unroll
        for (int r = 0; r < 16; ++r) o[d][r] = 0.f;
    float R = 0.f; bool wdone = false;
    u32x4 sk0, sk1, sv0, sv1;
    { const int kt = NT - 1; sk0 = *(const u32x4*)(kg0 + (size_t)kt * 64 * 4096); sk1 = *(const u32x4*)(kg1 + (size_t)kt * 64 * 4096); sv0 = *(const u32x4*)(vg0 + kt * 64); sv1 = *(const u32x4*)(vg1 + kt * 64); }
    *(LAS u32x4*)(Kb + kl0) = knorm8(sk0, kga, kgb); *(LAS u32x4*)(Kb + kl1) = knorm8(sk1, kga, kgb); *(LAS u32x4*)(Vb + vl0) = sv0; *(LAS u32x4*)(Vb + vl1) = sv1;
    __syncthreads();
    int buf = 0;
    for (int kt = NT - 1; kt >= 0; --kt) {
        if (kt > 0) { const int kn = kt - 1; sk0 = *(const u32x4*)(kg0 + (size_t)kn * 64 * 4096); sk1 = *(const u32x4*)(kg1 + (size_t)kn * 64 * 4096); sv0 = *(const u32x4*)(vg0 + kn * 64); sv1 = *(const u32x4*)(vg1 + kn * 64); }
        if (!wdone && kt * 64 < q0 + wid * 32 + 31) {
            const LAS unsigned char* kb_ = Kb + buf * AK_BUF + kfo; const LAS unsigned char* vb_ = Vb + buf * AV_BUF + vfo;
            f32x16 p[2];
#pragma unroll
            for (int kb = 0; kb < 2; ++kb) {
#pragma unroll
                for (int r = 0; r < 16; ++r) p[kb][r] = 0.f;
#pragma unroll
                for (int ks = 0; ks < 8; ++ks) { const bf16x8 a = *(const LAS bf16x8*)(kb_ + kb * 32 * AK_ROWB + ks * 32); p[kb] = __builtin_amdgcn_mfma_f32_32x32x16_bf16(a, qr[ks], p[kb], 0, 0, 0); }
            }
            const bool needmask = (kt * 64 + 63 >= q0 + wid * 32);
            float T[2];
#pragma unroll
            for (int kb = 1; kb >= 0; --kb) {
                float run = 0.f; const int s0 = kt * 64 + kb * 32 + hi * 16;
#pragma unroll
                for (int r = 15; r >= 0; --r) {
                    const float z = p[kb][r];
                    const float e = __builtin_amdgcn_exp2f(z);
                    float sp = __builtin_amdgcn_logf(1.0f + e);
                    float a = __builtin_amdgcn_exp2f(z - sp - run);
                    if (needmask && !(s0 + r < tq)) { sp = 0.f; a = 0.f; }
                    run += sp; p[kb][r] = a; }
                T[kb] = run; }
            const float T0o = __shfl_xor(T[0], 32), T1o = __shfl_xor(T[1], 32);
            const float base1 = R + (hi == 0 ? T1o : 0.f), base0 = R + T[1] + T1o + (hi == 0 ? T0o : 0.f);
            const float f0 = __builtin_amdgcn_exp2f(-base0), f1 = __builtin_amdgcn_exp2f(-base1);
            R += (T[0] + T0o) + (T[1] + T1o);
            bf16x8 pa[2][2];
#pragma unroll
            for (int kb = 0; kb < 2; ++kb) { const float f = kb ? f1 : f0;
#pragma unroll
                for (int s2 = 0; s2 < 2; ++s2) { u32x4 w;
                    w.x = pk2(p[kb][8 * s2 + 0] * f, p[kb][8 * s2 + 1] * f); w.y = pk2(p[kb][8 * s2 + 2] * f, p[kb][8 * s2 + 3] * f);
                    w.z = pk2(p[kb][8 * s2 + 4] * f, p[kb][8 * s2 + 5] * f); w.w = pk2(p[kb][8 * s2 + 6] * f, p[kb][8 * s2 + 7] * f);
                    pa[kb][s2] = __builtin_bit_cast(bf16x8, w); } }
#pragma unroll
            for (int d = 0; d < 4; ++d)
#pragma unroll
                for (int kb = 0; kb < 2; ++kb)
#pragma unroll
                    for (int s2 = 0; s2 < 2; ++s2) { const bf16x8 vb = *(const LAS bf16x8*)(vb_ + d * 32 * AV_ROWB + kb * 64 + s2 * 16); o[d] = __builtin_amdgcn_mfma_f32_32x32x16_bf16(pa[kb][s2], vb, o[d], 0, 0, 0); }
            wdone = __all(R >= ATT_DONE_LOG2) != 0;
        }
        if (lane == 0) flags[(kt & 1) * 8 + wid] = wdone ? 1u : 0u;
        if (kt > 0) { const int nb = buf ^ 1; *(LAS u32x4*)(Kb + nb * AK_BUF + kl0) = knorm8(sk0, kga, kgb); *(LAS u32x4*)(Kb + nb * AK_BUF + kl1) = knorm8(sk1, kga, kgb); *(LAS u32x4*)(Vb + nb * AV_BUF + vl0) = sv0; *(LAS u32x4*)(Vb + nb * AV_BUF + vl1) = sv1; }
        __syncthreads();
        buf ^= 1;
        { const u32x4 fa = *(const LAS u32x4*)(flags + (kt & 1) * 8), fb = *(const LAS u32x4*)(flags + (kt & 1) * 8 + 4);
          if ((fa[0] & fa[1] & fa[2] & fa[3] & fb[0] & fb[1] & fb[2] & fb[3]) != 0u) break; }
    }
    bf16_t* op = O + (size_t)(b * SEQ + q0 + wid * 32) * DM + h * HD + r32;
#pragma unroll
    for (int r = 0; r < 16; ++r) { const int qrow = (r & 3) + 8 * (r >> 2) + 4 * hi;
#pragma unroll
        for (int d = 0; d < 4; ++d) op[(size_t)qrow * DM + d * 32] = (bf16_t)(pk2(o[d][r], 0.f) & 0xffffu); }
    __syncthreads();
}
__device__ __forceinline__ void attn_phase(const bf16_t* QK, const bf16_t* VT, bf16_t* O, const float* qg, const float* kg, LAS unsigned char* lds, int tid, int wid, int lane, int bid) {
    for (int pi = bid; pi < 256; pi += gridDim.x) {
        const int bh = pi >> 2, s4 = pi & 3;
        attn_unit(bh / NHEAD, bh % NHEAD, 7 - s4, QK, VT, O, qg, kg, lds, tid, wid, lane);
        attn_unit(bh / NHEAD, bh % NHEAD, s4, QK, VT, O, qg, kg, lds, tid, wid, lane);
    }
}

__device__ __forceinline__ void sincos_2pi(float rev, float& s, float& c) {
    rev -= rintf(rev);
    const float kq = rintf(rev * 4.0f); const float a = (rev - kq * 0.25f) * 6.283185307179586f;
    const float a2 = a * a;
    const float sn = a * (1.0f + a2 * (-1.6666667e-1f + a2 * (8.3333310e-3f + a2 * (-1.98409e-4f + a2 * 2.7526e-6f))));
    const float cs = 1.0f + a2 * (-0.5f + a2 * (4.16666418e-2f + a2 * (-1.388731625e-3f + a2 * 2.443315711e-5f)));
    const int k = ((int)kq) & 3;
    s = (k == 0) ? sn : (k == 1) ? cs : (k == 2) ? -sn : -cs;
    c = (k == 0) ? cs : (k == 1) ? -sn : (k == 2) ? -cs : sn;
}
__device__ __forceinline__ void s5_disc(float lr, float li, float step, float& lbr, float& lbi, float& fr, float& fi) {
    const float mag = expf(lr * step); float sn, cs; sincos_2pi(li * step * 0.15915494309189535f, sn, cs);
    lbr = mag * cs; lbi = mag * sn;
    const float den = lr * lr + li * li;
    fr = ((lbr - 1.0f) * lr + lbi * li) / den; fi = (lbi * lr - (lbr - 1.0f) * li) / den;
}
constexpr int S5_XS_ROWB = 272, S5_XS_BUF = 65 * S5_XS_ROWB, S5_PAIR_BYTES = 2 * S5_XS_BUF;
__device__ __forceinline__ void cfma(float& orr, float& oi, float ar, float ai, float xr, float xi, float cr, float ci) {
    orr = fmaf(ar, xr, fmaf(-ai, xi, cr)); oi = fmaf(ar, xi, fmaf(ai, xr, ci));
}
__device__ __forceinline__ float other_half(float x) {
    const unsigned u = __float_as_uint(x); auto rr = __builtin_amdgcn_permlane32_swap(u, u, false, false);
    return __uint_as_float(rr[0] ^ rr[1] ^ u);
}
#define S5_BAR() asm volatile("s_waitcnt lgkmcnt(0)\n\ts_barrier" ::: "memory")
__device__ __forceinline__ void s5_phase(const bf16_t* __restrict__ HN, bf16_t* __restrict__ Y, const float* __restrict__ rsq, const float* __restrict__ gmix, const float* lam_re, const float* lam_im, const float* log_step,
                                         const float* b_re, const float* b_im, const float* c_re, const float* c_im, const float* dskip,
                                         LAS unsigned char* lds, int tid, int wid, int lane, int bid) {
    const int hf = (wid >> 1) & 1, hw = (wid & 1) + 2 * (wid >> 2), r32 = lane & 31, hi = lane >> 5, l16 = lane & 15, kq = lane >> 4;
    LAS unsigned char* XS = lds + hf * S5_PAIR_BYTES;
    LAS float* RT = (LAS float*)(lds + 2 * S5_PAIR_BYTES);
    constexpr int NC = SEQ / 64;
    for (int pr0 = bid * 2; pr0 < NB * SSM_G; pr0 += gridDim.x * 2) {
        const int pr = pr0 + hf, b = pr / SSM_G, g = pr % SSM_G;
        for (int t = tid; t < SEQ; t += NTHR) RT[t] = rstd_of(row_ssq(rsq, b * SEQ + t, 8));
        __syncthreads();
        const bf16_t* ubase = HN + (size_t)(b * SEQ) * DM + g * SSM_H;
        if (hw < 2) {
            const int p = 32 * hw + r32;
            const float step = expf(log_step[g]);
            float lbr, lbi, fr, fi; s5_disc(lam_re[g * SSM_P + p], lam_im[g * SSM_P + p], step, lbr, lbi, fr, fi);
            bf16x8 bbr, bbi;
            { const float* br = b_re + (size_t)(g * SSM_P + p) * SSM_H + hi * 8; const float* bi = b_im + (size_t)(g * SSM_P + p) * SSM_H + hi * 8;
              float vr[8], vi[8];
#pragma unroll
              for (int j = 0; j < 8; ++j) { vr[j] = fr * br[j] - fi * bi[j]; vi[j] = fr * bi[j] + fi * br[j]; }
              u32x4 w; w.x = pk2(vr[0], vr[1]); w.y = pk2(vr[2], vr[3]); w.z = pk2(vr[4], vr[5]); w.w = pk2(vr[6], vr[7]); bbr = __builtin_bit_cast(bf16x8, w);
              w.x = pk2(vi[0], vi[1]); w.y = pk2(vi[2], vi[3]); w.z = pk2(vi[4], vi[5]); w.w = pk2(vi[6], vi[7]); bbi = __builtin_bit_cast(bf16x8, w); }
            float gA[8];
#pragma unroll
            for (int j = 0; j < 8; ++j) gA[j] = gmix[g * SSM_H + hi * 8 + j];
            const float l2r = lbr * lbr - lbi * lbi, l2i = 2.0f * lbr * lbi, l3r = l2r * lbr - l2i * lbi, l3i = l2r * lbi + l2i * lbr, l4r = l2r * l2r - l2i * l2i, l4i = 2.0f * l2r * l2i;
            float xr = 0.f, xi = 0.f;
            u32x4 ua[2];
#pragma unroll
            for (int mb = 0; mb < 2; ++mb) ua[mb] = *(const u32x4*)(ubase + (size_t)(mb * 32 + r32) * DM + hi * 8);
            for (int c = 0; c <= NC; ++c) {
                if (c < NC) {
                    LAS unsigned char* xs = XS + (c & 1) * S5_XS_BUF + p * 4;
                    u32x4 un[2] = {ua[0], ua[1]};
                    if (c + 1 < NC) {
#pragma unroll
                        for (int mb = 0; mb < 2; ++mb) un[mb] = *(const u32x4*)(ubase + (size_t)((c + 1) * 64 + mb * 32 + r32) * DM + hi * 8); }
#pragma unroll
                    for (int mb = 0; mb < 2; ++mb) {
                        const float rs = RT[c * 64 + mb * 32 + r32]; u32x4 o;
#pragma unroll
                        for (int q = 0; q < 4; ++q) o[q] = pk2(bflo(ua[mb][q]) * rs * gA[2 * q], bfhi(ua[mb][q]) * rs * gA[2 * q + 1]);
                        f32x16 zr, zi;
#pragma unroll
                        for (int r = 0; r < 16; ++r) { zr[r] = 0.f; zi[r] = 0.f; }
                        zr = __builtin_amdgcn_mfma_f32_32x32x16_bf16(__builtin_bit_cast(bf16x8, o), bbr, zr, 0, 0, 0);
                        zi = __builtin_amdgcn_mfma_f32_32x32x16_bf16(__builtin_bit_cast(bf16x8, o), bbi, zi, 0, 0, 0);
#pragma unroll
                        for (int grp = 0; grp < 8; ++grp) {
                            const int r0 = 4 * (grp >> 1);
                            float c1r, c1i, fr_, fi_, er, ei;
                            cfma(c1r, c1i, lbr, lbi, zr[r0], zi[r0], zr[r0 + 1], zi[r0 + 1]);
                            cfma(fr_, fi_, lbr, lbi, c1r, c1i, zr[r0 + 2], zi[r0 + 2]);
                            cfma(er, ei, lbr, lbi, fr_, fi_, zr[r0 + 3], zi[r0 + 3]);
                            const float Xr = other_half(xr), Xi = other_half(xi);
                            float ar, ai, br_, bi_, cr, ci;
                            cfma(ar, ai, lbr, lbi, Xr, Xi, zr[r0], zi[r0]);
                            cfma(br_, bi_, l2r, l2i, Xr, Xi, c1r, c1i);
                            cfma(cr, ci, l3r, l3i, Xr, Xi, fr_, fi_);
                            cfma(xr, xi, l4r, l4i, Xr, Xi, er, ei);
                            const bool act = (hi == (grp & 1));
                            LAS unsigned char* q = xs + (act ? (mb * 32 + 4 * grp) : 64) * S5_XS_ROWB; const int st = act ? S5_XS_ROWB : 0;
                            *(LAS unsigned*)(q) = pk2(ar, ai); *(LAS unsigned*)(q + st) = pk2(br_, bi_); *(LAS unsigned*)(q + 2 * st) = pk2(cr, ci); *(LAS unsigned*)(q + 3 * st) = pk2(xr, xi);
                        }
                    }
                    ua[0] = un[0]; ua[1] = un[1];
                }
                S5_BAR();
            }
        } else {
            const int pw = hw - 2;
            bf16x8 cm[4];
#pragma unroll
            for (int ks = 0; ks < 4; ++ks) { const int p0 = (ks * 32 + kq * 8) >> 1; float v[8];
                const float* sr = c_re + (size_t)(g * SSM_H + l16) * SSM_P + p0; const float* si = c_im + (size_t)(g * SSM_H + l16) * SSM_P + p0;
#pragma unroll
                for (int j = 0; j < 4; ++j) { v[2 * j] = sr[j]; v[2 * j + 1] = -si[j]; }
                u32x4 w; w.x = pk2(v[0], v[1]); w.y = pk2(v[2], v[3]); w.z = pk2(v[4], v[5]); w.w = pk2(v[6], v[7]); cm[ks] = __builtin_bit_cast(bf16x8, w); }
            const float dsk = dskip[g * SSM_H + l16], gS = gmix[g * SSM_H + l16];
            unsigned short usn[2][4];
#pragma unroll
            for (int k2 = 0; k2 < 2; ++k2)
#pragma unroll
                for (int i = 0; i < 4; ++i) usn[k2][i] = ubase[(size_t)(16 * (2 * pw + k2) + 4 * kq + i) * DM + l16];
            for (int c = 0; c <= NC; ++c) {
                if (c > 0) {
                    const int cc = c - 1;
                    unsigned short us[2][4];
#pragma unroll
                    for (int k2 = 0; k2 < 2; ++k2)
#pragma unroll
                        for (int i = 0; i < 4; ++i) us[k2][i] = usn[k2][i];
                    if (c < NC) { const bf16_t* urow = ubase + (size_t)(c * 64) * DM;
#pragma unroll
                        for (int k2 = 0; k2 < 2; ++k2)
#pragma unroll
                            for (int i = 0; i < 4; ++i) usn[k2][i] = urow[(size_t)(16 * (2 * pw + k2) + 4 * kq + i) * DM + l16]; }
                    const LAS unsigned char* xs = XS + (cc & 1) * S5_XS_BUF;
#pragma unroll
                    for (int k2 = 0; k2 < 2; ++k2) { const int tb = 16 * (2 * pw + k2);
                        f32x4 y = {0.f, 0.f, 0.f, 0.f};
#pragma unroll
                        for (int ks = 0; ks < 4; ++ks) { const bf16x8 xa = *(const LAS bf16x8*)(xs + (tb + l16) * S5_XS_ROWB + (ks * 32 + kq * 8) * 2); y = __builtin_amdgcn_mfma_f32_16x16x32_bf16(xa, cm[ks], y, 0, 0, 0); }
#pragma unroll
                        for (int i = 0; i < 4; ++i) { const int tk = tb + 4 * kq + i; const float v = y[i] + dsk * (bf2f(us[k2][i]) * RT[cc * 64 + tk] * gS);
                            const float a2 = 1.5957691216057308f * (v + 0.044715f * v * v * v);
                            Y[(size_t)(b * SEQ + cc * 64 + tk) * DM + g * SSM_H + l16] = (bf16_t)(pk2(v * fast_sigmoid(a2), 0.f) & 0xffffu); } }
                }
                S5_BAR();
            }
        }
        __syncthreads();
    }
}

#define XB_TMO      128
#define XB_XCNT(j)  (256  + 64 * (j))
#define XB_XSUB(j)  (1280 + 64 * (j))
#define XB_XGEN(j)  (2304 + 64 * (j))
#define XB_TOP      3328
#define XB_TOPGEN   3392
#define XCD_BAR_WORDS 3456
#define XB_SPIN_CAP (1u << 22)
constexpr int CTL_QUEUE_WORD = 4096;
constexpr size_t CTL_ZERO_BYTES = (CTL_QUEUE_WORD + 64 * 4) * sizeof(unsigned);
__device__ __forceinline__ unsigned xb_ld(unsigned* p)              { return __hip_atomic_load(p, __ATOMIC_RELAXED, __HIP_MEMORY_SCOPE_AGENT); }
__device__ __forceinline__ unsigned xb_add(unsigned* p, unsigned v) { return __hip_atomic_fetch_add(p, v, __ATOMIC_RELAXED, __HIP_MEMORY_SCOPE_AGENT); }
__device__ __forceinline__ unsigned xb_xcc_id() { return (unsigned)__builtin_amdgcn_s_getreg((3 << 11) | 20) & 0xFu; }
#define XB_SPIN(cond, bar) do { unsigned _sp = 0; while (cond) { __builtin_amdgcn_s_sleep(1); \
    if ((++_sp & 255u) == 0u) { if (xb_ld(&(bar)[XB_TMO])) break; if (_sp > XB_SPIN_CAP) { atomicAdd(&(bar)[XB_TMO], 1u); break; } } } } while (0)
struct XcdBarrier { unsigned* bar; unsigned x; volatile LAS unsigned* st; };
__device__ __forceinline__ XcdBarrier xcd_barrier_post(unsigned* bar, volatile LAS unsigned* st) {
    XcdBarrier b; b.bar = bar; b.x = xb_xcc_id(); b.st = st;
    if (threadIdx.x == 0) (void)xb_add(&bar[XB_XCNT(b.x)], 1u);
    return b;
}
__device__ __forceinline__ void xcd_barrier_complete(unsigned* bar, unsigned x, unsigned& nloc, unsigned& nx) {
    const unsigned G = gridDim.x * gridDim.y * gridDim.z;
    unsigned sum, cnt, mine, sp = 0u;
    for (;;) {
        sum = 0u; cnt = 0u; mine = 0u;
#pragma unroll
        for (unsigned j = 0; j < 16; ++j) { const unsigned c = xb_ld(&bar[XB_XCNT(j)]); sum += c; cnt += (c > 0u) ? 1u : 0u; mine = (j == x) ? c : mine; }
        if (sum == G) break;
        __builtin_amdgcn_s_sleep(1);
        if ((++sp & 255u) == 0u) { if (xb_ld(&bar[XB_TMO])) break; if (sp > XB_SPIN_CAP) { atomicAdd(&bar[XB_TMO], 1u); break; } }
    }
    nloc = mine > 0u ? mine : 1u; nx = cnt > 0u ? cnt : 1u;
}
__device__ __forceinline__ void xcd_barrier(const XcdBarrier& b) {
    asm volatile("s_waitcnt vmcnt(0)" ::: "memory");
    __syncthreads();
    if (threadIdx.x == 0) {
        unsigned* bar = b.bar;
        __builtin_amdgcn_s_waitcnt(0);
        unsigned nloc = b.st[0], nx = b.st[1];
        if (nloc == 0u) { xcd_barrier_complete(bar, b.x, nloc, nx); b.st[0] = nloc; b.st[1] = nx; }
        const unsigned old = xb_add(&bar[XB_XSUB(b.x)], 1u);
        const unsigned gen = old / nloc;
        if (old + 1u == (gen + 1u) * nloc) {
            __builtin_amdgcn_fence(__ATOMIC_RELEASE, "agent");
            asm volatile("s_waitcnt vmcnt(0)" ::: "memory");
            const unsigned og = xb_add(&bar[XB_TOP], 1u);
            const unsigned tg = og / nx;
            if (og + 1u == (tg + 1u) * nx) xb_add(&bar[XB_TOPGEN], 1u);
            else XB_SPIN(xb_ld(&bar[XB_TOPGEN]) == tg, bar);
            __builtin_amdgcn_fence(__ATOMIC_ACQUIRE, "agent");
            xb_add(&bar[XB_XGEN(b.x)], 1u);
            asm volatile("s_waitcnt vmcnt(0)" ::: "memory");
        } else {
            XB_SPIN(xb_ld(&bar[XB_XGEN(b.x)]) == gen, bar);
            __builtin_amdgcn_fence(__ATOMIC_ACQUIRE, "agent");
            asm volatile("s_waitcnt vmcnt(0)" ::: "memory");
        }
    }
    __syncthreads();
}

struct Args { const float* in[24]; float* out; unsigned char* ws; int ph_lo, ph_hi; };
enum { I_X = 0, I_NMG, I_NFG, I_POOLW, I_POOLB, I_POOLS, I_QKVW, I_QG, I_KG, I_OW, I_LRE, I_LIM, I_LSTEP, I_BRE, I_BIM, I_CRE, I_CIM, I_SD, I_GLUW, I_GLUB, I_UPW, I_CONVW, I_CONVB, I_DNW };

__device__ __forceinline__ const Args* kargs();
__device__ __forceinline__ const float* IN(int i);
__device__ __forceinline__ bf16_t* WSP(size_t off);
__device__ __forceinline__ int up_dn_items() { return 32 * 176 + 88 * 32; }
__device__ __forceinline__ void convert_up_dn(int it, int l, LAS float* scr, int lane) {
    if (tr_matrix(it, IN(I_UPW) + (size_t)l * DM * DFF2, DM, DFF2, WSP(WS_UPW) + (size_t)l * DFF2 * DM, 0, DFF, IN(I_NFG) + (size_t)l * DM, scr, lane)) return;
    (void)tr_matrix(it, IN(I_DNW) + (size_t)l * DFF * DM, DFF, DM, WSP(WS_DNW) + (size_t)l * DM * DFF, 0, 0, nullptr, scr, lane);
}
__device__ __forceinline__ void convert_layer(int l, unsigned* ctr, LAS unsigned char* lds, int tid, int wid, int lane) {
    const int kind = l % 3;
    const int nmix = (kind == 1) ? (32 * 96 + 32 * 32) : (kind == 2) ? (32 * 64) : 0;
    const int total = nmix + up_dn_items();
    LAS float* scr = (LAS float*)(lds + wid * (64 * 65 * 4));
    volatile LAS unsigned* slot = (volatile LAS unsigned*)(lds + LDS_BYTES - 8);
    for (;;) {
        if (tid == 0) *slot = __hip_atomic_fetch_add(ctr, 16u, __ATOMIC_RELAXED, __HIP_MEMORY_SCOPE_AGENT);
        __syncthreads();
        const int base = (int)*slot;
        __syncthreads();
        if (base >= total) break;
#pragma unroll 1
        for (int k = 0; k < 2; ++k) { int it = base + k * NWAVE + wid; if (it >= total) continue;
            if (kind == 1) { if (tr_matrix(it, IN(I_QKVW), DM, 3 * DM, WSP(WS_QKVW), 0, 0, IN(I_NMG) + (size_t)l * DM, scr, lane)) continue;
                             if (tr_matrix(it, IN(I_OW), DM, DM, WSP(WS_OW), 0, 0, nullptr, scr, lane)) continue; }
            if (kind == 2) { if (tr_matrix(it, IN(I_GLUW), DM, 2 * DM, WSP(WS_GLUW), 0, DM, nullptr, scr, lane)) continue; }
            convert_up_dn(it, l, scr, lane); }
    }
}
__device__ __forceinline__ const Args* kargs() { return (const Args*)__builtin_amdgcn_kernarg_segment_ptr(); }
__device__ __forceinline__ const float* IN(int i) { int z = 0; asm volatile("" : "+s"(z)); return kargs()->in[i + z]; }
__device__ __forceinline__ float* OUTP() { int z = 0; asm volatile("" : "+s"(z)); return (&kargs()->out)[z]; }
__device__ __forceinline__ float* RSQP(int k) { int z = 0; asm volatile("" : "+s"(z)); return (float*)((&kargs()->ws)[z] + WS_RSQ) + (size_t)k * MTOK * 64; }
__device__ __forceinline__ bf16_t* WSP(size_t off) { int z = 0; asm volatile("" : "+s"(z)); return (bf16_t*)((&kargs()->ws)[z] + off); }

__global__ void __launch_bounds__(NTHR, 2) mega_fwd(Args a) {
    extern __shared__ __attribute__((aligned(16))) unsigned char lds_raw[];
    LAS unsigned char* lds = (LAS unsigned char*)lds_raw;
    cg::grid_group grid = cg::this_grid();
#define G_ ((int)gridDim.x)
#define GW_ (bid * NWAVE + wid)
#define NGW_ (G_ * NWAVE)
    const int lo = a.ph_lo, hi = a.ph_hi;
    int ph = 0;
    volatile LAS unsigned* xst = (volatile LAS unsigned*)(lds + LDS_BYTES - 16);
    if (threadIdx.x < 2) xst[threadIdx.x] = 0u;
    if (a.ph_lo < 0) grid.sync();
    (void)xcd_barrier_post((unsigned*)(a.ws + WS_CTL), xst);
#define PH_BEGIN if (ph >= lo && ph < hi) { int tid = threadIdx.x; asm volatile("" : "+v"(tid)); int bid = blockIdx.x; asm volatile("" : "+s"(bid)); const int lane = tid & 63, wid = __builtin_amdgcn_readfirstlane(tid >> 6); (void)lane; (void)wid; (void)bid;
#define PH_END   if (ph + 1 < hi) { XcdBarrier xb_; xb_.bar = (unsigned*)WSP(WS_CTL); xb_.x = xb_xcc_id(); xb_.st = xst; xcd_barrier(xb_); } } ++ph;

    PH_BEGIN
        LAS float* scr = (LAS float*)(lds + wid * (64 * 65 * 4));
        constexpr int I_POOL = 8 * 8;
        const int NIT = 8 * I_POOL + up_dn_items();
        for (int it0 = GW_; it0 < NIT; it0 += NGW_) {
            int it = it0; bool done = false;
            for (int m = 0; m < 8 && !done; ++m) done = tr_matrix(it, IN(I_POOLW) + (size_t)m * 512 * 512, 512, 512, WSP(WS_POOLW) + (size_t)(m >> 2) * 2048 * 512, (m & 3) * 512, 0, nullptr, scr, lane);
            if (!done) convert_up_dn(it, 0, scr, lane);
        }
        __syncthreads();
        pool_phase(IN(I_X), nullptr, IN(I_NMG), nullptr, WSP(WS_MIX), lds, tid, wid, lane, bid);
    PH_END

    for (int li = 0; li < DEPTH; ++li) {
        const int kind = li % 3, lj = li / 3;
        if (kind == 0) {
            if (li != 0) { PH_BEGIN pool_phase(nullptr, WSP(WS_HN), IN(I_NMG) + (size_t)li * DM, RSQP(2 * li - 1), WSP(WS_MIX), lds, tid, wid, lane, bid); PH_END }
            PH_BEGIN
                pg8::Gemm g{WSP(WS_MIX), WSP(WS_POOLW) + (size_t)lj * 2048 * 512}; pg8::StaticOrder S; S.init(MTOK, DM, G_, bid);
                if (li == 0) { pg8::EpiResid<0> E{IN(I_X), nullptr, IN(I_POOLB) + (size_t)lj * DM, IN(I_POOLS) + (size_t)lj * DM, WSP(WS_HN), RSQP(2 * li)}; pg8::gemm_phase<512, DM, 512, 2, false>(lds, g, S, E, tid); }
                else { pg8::EpiResid<1> E{nullptr, nullptr, IN(I_POOLB) + (size_t)lj * DM, IN(I_POOLS) + (size_t)lj * DM, WSP(WS_HN), RSQP(2 * li)}; pg8::gemm_phase<512, DM, 512, 2, false>(lds, g, S, E, tid); }
            PH_END
        } else if (kind == 1) {
            PH_BEGIN
                { pg8::Gemm g{WSP(WS_HN), WSP(WS_QKVW)}; pg8::StaticOrder S; S.init(MTOK, 2 * DM, G_, bid); pg8::EpiBf16<1> E{WSP(WS_QK), 2 * DM, RSQP(2 * li - 1), 8, lds}; pg8::gemm_phase<DM, DM, DM, 0, false>(lds, g, S, E, tid); }
                { pg8::Gemm g{WSP(WS_QKVW) + (size_t)2 * DM * DM, WSP(WS_HN)}; pg8::StaticOrder S; S.init(DM, MTOK, G_, bid); pg8::EpiBf16<2> E{WSP(WS_VT), MTOK, RSQP(2 * li - 1), 8, lds}; pg8::gemm_phase<DM, DM, DM, 0, false>(lds, g, S, E, tid); }
            PH_END
            PH_BEGIN attn_phase(WSP(WS_QK), WSP(WS_VT), WSP(WS_MIX), IN(I_QG), IN(I_KG), lds, tid, wid, lane, bid); PH_END
            PH_BEGIN
                pg8::Gemm g{WSP(WS_MIX), WSP(WS_OW)}; pg8::StaticOrder S; S.init(MTOK, DM, G_, bid);
                pg8::EpiResid<1> E{nullptr, nullptr, nullptr, nullptr, WSP(WS_HN), RSQP(2 * li)}; pg8::gemm_phase<DM, DM, DM, 0, false>(lds, g, S, E, tid);
            PH_END
        } else {
            PH_BEGIN s5_phase(WSP(WS_HN), WSP(WS_MIX), RSQP(2 * li - 1), IN(I_NMG) + (size_t)li * DM, IN(I_LRE), IN(I_LIM), IN(I_LSTEP), IN(I_BRE), IN(I_BIM), IN(I_CRE), IN(I_CIM), IN(I_SD), lds, tid, wid, lane, bid); PH_END
            PH_BEGIN
                pg8::Gemm g{WSP(WS_MIX), WSP(WS_GLUW)}; pg8::StaticOrder S; S.init(MTOK, 2 * DM, G_, bid);
                pg8::EpiGlu E{IN(I_GLUB), WSP(WS_HN), RSQP(2 * li)}; pg8::gemm_phase<DM, DM, DM, 0, false>(lds, g, S, E, tid);
            PH_END
        }
        PH_BEGIN
            pg8::Gemm g{WSP(WS_HN), WSP(WS_UPW) + (size_t)li * DFF2 * DM}; pg8::StaticOrder S; S.init(MTOK, DFF2, G_, bid);
            pg8::EpiConv E{(unsigned char*)WSP(0), IN(I_CONVW) + (size_t)li * 3 * DFF2, IN(I_CONVB) + (size_t)li * DFF2, 2 * li, (kind == 2) ? 16 : 8, lds}; pg8::gemm_phase<DM, DM, DM, 0, true>(lds, g, S, E, tid);
            if (li + 1 < DEPTH)
                convert_layer(li + 1, (unsigned*)WSP(WS_CTL) + CTL_QUEUE_WORD + 64 * li, lds, tid, wid, lane);
        PH_END
        PH_BEGIN
            pg8::Gemm g{WSP(WS_ACT), WSP(WS_DNW) + (size_t)li * DM * DFF}; pg8::StaticOrder S; S.init(MTOK, DM, G_, bid);
            { pg8::Unit fu; int lastpm = -1; for (int i = 0; S.next(i, fu); ++i) if (fu.pm != lastpm) { lastpm = fu.pm; convfix_tile((const float*)WSP(WS_UP), IN(I_CONVW) + (size_t)li * 3 * DFF2, IN(I_CONVB) + (size_t)li * DFF2, WSP(WS_ACT), fu.pm, tid); }
              asm volatile("s_waitcnt vmcnt(0)" ::: "memory"); __syncthreads(); }
            if (li < DEPTH - 1) { pg8::EpiResid<1> E{nullptr, nullptr, nullptr, nullptr, WSP(WS_HN), RSQP(2 * li + 1)}; pg8::gemm_phase<DFF, DFF, DFF, 0, false>(lds, g, S, E, tid); }
            else { pg8::EpiResid<2> E{nullptr, OUTP(), nullptr, nullptr, WSP(WS_HN), nullptr}; pg8::gemm_phase<DFF, DFF, DFF, 0, false>(lds, g, S, E, tid); }
        PH_END
    }
#undef PH_BEGIN
#undef PH_END
}
constexpr int N_PHASES = 17;

extern "C" void kernel_launch(void* const* d_in, const int* in_sizes, int n_in, void* d_out, int out_size, void* d_ws, size_t ws_size, hipStream_t stream) {
    static int grid = 0;
    if (grid == 0) {
        if (n_in != 24 || out_size != MTOK * DM || ws_size < WS_END) { fprintf(stderr, "kernel_launch: unexpected shapes (n_in %d out %d ws %zu)\n", n_in, out_size, ws_size); grid = -1; return; }
        int dev = 0, cus = 0, per_cu = 0;
        hipGetDevice(&dev); hipDeviceGetAttribute(&cus, hipDeviceAttributeMultiprocessorCount, dev);
        if (hipFuncSetAttribute((const void*)mega_fwd, hipFuncAttributeMaxDynamicSharedMemorySize, LDS_BYTES) != hipSuccess) { fprintf(stderr, "kernel_launch: hipFuncSetAttribute failed\n"); grid = -1; return; }
        if (hipOccupancyMaxActiveBlocksPerMultiprocessor(&per_cu, (const void*)mega_fwd, NTHR, LDS_BYTES) != hipSuccess || per_cu < 1) { fprintf(stderr, "kernel_launch: occupancy query says %d\n", per_cu); per_cu = 1; }
        (void)hipGetLastError();
        grid = cus * per_cu;
        if (grid > 256) grid = 256;
    }
    if (grid < 0) return;
    Args a{};
    for (int i = 0; i < 24; ++i) a.in[i] = (const float*)d_in[i];
    a.out = (float*)d_out; a.ws = (unsigned char*)d_ws;
    if (hipMemsetAsync((char*)d_ws + WS_CTL, 0, CTL_ZERO_BYTES, stream) != hipSuccess) { fprintf(stderr, "kernel_launch: hipMemsetAsync failed\n"); return; }
#if MK_MULTI
    for (int p = 0; p < N_PHASES; ++p) { a.ph_lo = p; a.ph_hi = p + 1; hipLaunchKernelGGL(mega_fwd, dim3(grid), dim3(NTHR), LDS_BYTES, stream, a); }
#else
    a.ph_lo = 0; a.ph_hi = N_PHASES;
    void* args[] = {&a};
    hipError_t e = hipLaunchCooperativeKernel((const void*)mega_fwd, dim3(grid), dim3(NTHR), args, LDS_BYTES, stream);
    if (e != hipSuccess) fprintf(stderr, "kernel_launch: cooperative launch failed: %s (grid %d)\n", hipGetErrorString(e), grid);
#endif
}
```

```cpp
#include <hip/hip_runtime.h>
#include <hip/hip_cooperative_groups.h>
#include <cstdio>
#include <cstdint>
namespace cg = cooperative_groups;

#ifndef MK_MULTI
#define MK_MULTI 0
#endif

#define LAS __attribute__((address_space(3)))
typedef unsigned short bf16_t;
typedef short bf16x8 __attribute__((ext_vector_type(8)));
typedef float f32x2 __attribute__((ext_vector_type(2)));
typedef float f32x4 __attribute__((ext_vector_type(4)));
typedef float f32x16 __attribute__((ext_vector_type(16)));
typedef unsigned u32x2 __attribute__((ext_vector_type(2)));
typedef unsigned u32x4 __attribute__((ext_vector_type(4)));
typedef __bf16 bf16x2_t __attribute__((ext_vector_type(2)));

constexpr int DM = 2048, NB = 4, SEQ = 2048, MTOK = NB * SEQ, DFF = 5632, DFF2 = 2 * DFF, DEPTH = 4;
constexpr int NHEAD = 16, HD = 128, SSM_G = 128, SSM_P = 64, SSM_H = 16;
constexpr float RMS_EPS = 1e-6f;
constexpr int NTHR = 512, NWAVE = 8;

constexpr size_t MiB = 1u << 20;
constexpr size_t WS_POOLW = 0;
constexpr size_t WS_QKVW = 4 * MiB;
constexpr size_t WS_OW = 28 * MiB;
constexpr size_t WS_GLUW = 36 * MiB;
constexpr size_t WS_UPW = 52 * MiB;
constexpr size_t WS_DNW = 228 * MiB;
constexpr size_t WS_HN = 320 * MiB;
constexpr size_t WS_MIX = 352 * MiB;
constexpr size_t WS_QK = 384 * MiB;
constexpr size_t WS_VT = 448 * MiB;
constexpr size_t WS_UP = 480 * MiB;
constexpr size_t WS_ACT = 656 * MiB;
constexpr size_t WS_RSQ = 746 * MiB;
constexpr size_t WS_CTL = 744 * MiB;
constexpr size_t WS_END = 762 * MiB;

constexpr int LDS_BYTES = 147456;

__device__ __forceinline__ unsigned pk2(float lo, float hi) { f32x2 v = {lo, hi}; bf16x2_t b = __builtin_convertvector(v, bf16x2_t); return __builtin_bit_cast(unsigned, b); }
__device__ __forceinline__ float bf2f(unsigned short h) { return __uint_as_float(((unsigned)h) << 16); }
__device__ __forceinline__ float bflo(unsigned w) { return __uint_as_float(w << 16); }
__device__ __forceinline__ float bfhi(unsigned w) { return __uint_as_float(w & 0xffff0000u); }
__device__ __forceinline__ float wave_sum(float v) {
#pragma unroll
    for (int o = 1; o < 64; o <<= 1) v += __shfl_xor(v, o);
    return v;
}
__device__ __forceinline__ float rstd_of(float ssq) { return __builtin_amdgcn_rsqf(ssq * (1.0f / DM) + RMS_EPS); }
__device__ __forceinline__ float row_ssq(const float* part, int row, int np4) { const f32x4* p = (const f32x4*)(part + (size_t)row * 64); f32x4 a = p[0];
#pragma unroll 8
    for (int j = 1; j < np4; ++j) a += p[j];
    return (a[0] + a[1]) + (a[2] + a[3]); }
__device__ __forceinline__ float fast_sigmoid(float g) { return __builtin_amdgcn_rcpf(1.0f + __expf(-g)); }

namespace pg8 {
constexpr int BM = 256, BK = 64, HALF = 128, HTB = HALF * BK * 2, STAGE_BYTES = 8 * HTB, NXCD = 8, WGM = 8;
__host__ __device__ __forceinline__ int lds_byte(int r, int c) { const int st = (r >> 4) * 2 + (c >> 5), rr = r & 15, cc = c & 31, ob = rr * 64 + cc * 2; return st * 1024 + (ob ^ (((ob >> 9) & 1) << 5)); }
__host__ __device__ __forceinline__ void stage_rc(int b, int& R, int& C) { const int st = b / 1024, sb = b % 1024, swz = sb ^ (((sb >> 9) & 1) << 5); R = (st >> 1) * 16 + swz / 64; C = (st & 1) * 32 + (swz % 64) / 2; }
__host__ __device__ __forceinline__ int perm32(int rho) { const int n = rho >> 4, i = rho & 15; return 8 * (i >> 2) + 4 * n + (i & 3); }

struct Unit { int pm, pn; int same_pm, same_pn; int seq, next_pn; };
struct Gemm { const bf16_t* A; const bf16_t* Bt; };

struct StaticOrder {
    int nM, nN, nwg, G, c;
    __host__ __device__ __forceinline__ void init(int M, int N, int G_, int c_) { nM = M / BM; nN = N / BM; nwg = nM * nN; G = G_; c = c_; }
    __host__ __device__ __forceinline__ bool next(int i, Unit& u) const {
        const long L = (long)i * G + c; if (L >= nwg) return false;
        int wgid = (int)L; { const int q = nwg / NXCD, r = nwg % NXCD, xcd = wgid % NXCD, off = wgid / NXCD; wgid = (xcd < r ? xcd * (q + 1) : r * (q + 1) + (xcd - r) * q) + off; }
        const int nig = WGM * nN, gid = wgid / nig, fm = gid * WGM, gsz = (nM - fm) < WGM ? (nM - fm) : WGM;
        u.pm = fm + ((wgid % nig) % gsz); u.pn = (wgid % nig) / gsz; return true;
    }
};

template <int MODE> struct EpiBf16 {
    bf16_t* O; int ldc; const float* rsq; int np4; LAS unsigned char* lds;
    __device__ __forceinline__ void operator()(const f32x4 (&acc)[2][2][4][2], const Unit& u, int wr, int wc, int fr, int fq) const {
        const int row0 = u.pm * BM + wr * 64 + fr, col0 = u.pn * BM + wc * 32 + 8 * fq;
        LAS float* ct = (LAS float*)(lds + 131072);
        if (MODE != 0 && !(MODE == 1 ? u.same_pm : u.same_pn)) {
            const int t = (wr * 4 + wc) * 64 + fq * 16 + fr;
            if (t < 256) ct[t] = rstd_of(row_ssq(rsq, (MODE == 1 ? u.pm : u.pn) * BM + t, np4));
            asm volatile("s_waitcnt lgkmcnt(0)\n\ts_barrier" ::: "memory");
        }
        f32x4 cs[2][2];
        if (MODE == 2) {
#pragma unroll
            for (int bj = 0; bj < 2; ++bj)
#pragma unroll
                for (int n = 0; n < 2; ++n) cs[bj][n] = *(const LAS f32x4*)(ct + wc * 32 + 8 * fq + bj * HALF + 4 * n);
        }
#pragma unroll
        for (int ai = 0; ai < 2; ++ai)
#pragma unroll
            for (int m = 0; m < 4; ++m) { const int row = row0 + ai * HALF + m * 16; bf16_t* rowp = O + (size_t)row * ldc + col0;
                float rs = 1.0f; if (MODE == 1) rs = ct[wr * 64 + fr + ai * HALF + m * 16];
#pragma unroll
                for (int bj = 0; bj < 2; ++bj) { f32x4 v0 = acc[ai][bj][m][0], v1 = acc[ai][bj][m][1];
                    if (MODE == 1) { v0 = v0 * rs; v1 = v1 * rs; }
                    if (MODE == 2) { v0 = v0 * cs[bj][0]; v1 = v1 * cs[bj][1]; }
                    u32x4 w; w.x = pk2(v0[0], v0[1]); w.y = pk2(v0[2], v0[3]); w.z = pk2(v1[0], v1[1]); w.w = pk2(v1[2], v1[3]);
                    *(u32x4*)(rowp + bj * HALF) = w; } }
    }
};
template <int MODE> struct EpiResid {
    const float* base; float* out; const float* bias; const float* scale; bf16_t* xb; float* rsq;
    __device__ __forceinline__ void pre(const Unit&, int, int, int, int) {}
    __device__ __forceinline__ void ldgrp(u32x4 (&d)[2][2], size_t off) const {
#pragma unroll
        for (int bj = 0; bj < 2; ++bj) {
            if (MODE == 0) { d[bj][0] = *(const u32x4*)(base + off + bj * HALF); d[bj][1] = *(const u32x4*)(base + off + bj * HALF + 4); }
            else { d[bj][0] = *(const u32x4*)(xb + off + bj * HALF); d[bj][1] = d[bj][0]; } }
    }
    __device__ __forceinline__ void operator()(const f32x4 (&acc)[2][2][4][2], const Unit& u, int wr, int wc, int fr, int fq) const {
        const int row0 = u.pm * BM + wr * 64 + fr, col0 = u.pn * BM + wc * 32 + 8 * fq;
        u32x4 cur[2][2], nxt[2][2], nx2[2][2];
        ldgrp(cur, (size_t)row0 * DM + col0); ldgrp(nxt, (size_t)(row0 + 16) * DM + col0);
#pragma unroll
        for (int j = 0; j < 8; ++j) { const int ai = j >> 2, m = j & 3; const int row = row0 + ai * HALF + m * 16; const size_t off = (size_t)row * DM + col0; float ss = 0.f;
            if (j < 6) ldgrp(nx2, (size_t)(row0 + ((j + 2) >> 2) * HALF + ((j + 2) & 3) * 16) * DM + col0);
#pragma unroll
            for (int bj = 0; bj < 2; ++bj) { f32x4 o[2];
#pragma unroll
                for (int n = 0; n < 2; ++n) { const int cc = bj * HALF + 4 * n;
                    f32x4 v = acc[ai][bj][m][n];
                    if (bias) { v = (v + *(const f32x4*)(bias + col0 + cc)) * *(const f32x4*)(scale + col0 + cc); }
                    f32x4 b;
                    if (MODE == 0) b = __builtin_bit_cast(f32x4, cur[bj][n]);
                    else { const unsigned w0 = n ? cur[bj][0].z : cur[bj][0].x, w1 = n ? cur[bj][0].w : cur[bj][0].y; b = (f32x4){bflo(w0), bfhi(w0), bflo(w1), bfhi(w1)}; }
                    o[n] = b + v;
                    if (MODE == 2) *(f32x4*)(out + off + cc) = o[n];
                    ss += (o[n][0] * o[n][0] + o[n][1] * o[n][1]) + (o[n][2] * o[n][2] + o[n][3] * o[n][3]); }
                if (MODE != 2) { u32x4 w; w.x = pk2(o[0][0], o[0][1]); w.y = pk2(o[0][2], o[0][3]); w.z = pk2(o[1][0], o[1][1]); w.w = pk2(o[1][2], o[1][3]); *(u32x4*)(xb + off + bj * HALF) = w; } }
            if (MODE != 2 && rsq) { ss += __shfl_xor(ss, 16); ss += __shfl_xor(ss, 32); if (fq == 0) rsq[(size_t)row * 64 + u.pn * 4 + wc] = ss; }
#pragma unroll
            for (int bj = 0; bj < 2; ++bj)
#pragma unroll
                for (int n = 0; n < 2; ++n) { cur[bj][n] = nxt[bj][n]; nxt[bj][n] = nx2[bj][n]; }
            asm volatile("" ::: "memory"); }
    }
};
struct EpiGlu {
    const float* bias; bf16_t* xb; float* rsq;
    __device__ __forceinline__ void pre(const Unit&, int, int, int, int) {}
    __device__ __forceinline__ void operator()(const f32x4 (&acc)[2][2][4][2], const Unit& u, int wr, int wc, int fr, int fq) const {
        const int row0 = u.pm * BM + wr * 64 + fr, col0 = u.pn * HALF + wc * 32 + 8 * fq;
        const f32x4 bv0 = *(const f32x4*)(bias + col0), bv1 = *(const f32x4*)(bias + col0 + 4), bg0 = *(const f32x4*)(bias + DM + col0), bg1 = *(const f32x4*)(bias + DM + col0 + 4);
        u32x4 cur = *(const u32x4*)(xb + (size_t)row0 * DM + col0), nxt = cur;
#pragma unroll
        for (int j = 0; j < 8; ++j) { const int ai = j >> 2, m = j & 3; const int row = row0 + ai * HALF + m * 16; const size_t off = (size_t)row * DM + col0; float ss = 0.f; f32x4 o[2];
            if (j < 7) nxt = *(const u32x4*)(xb + (size_t)(row0 + ((j + 1) >> 2) * HALF + ((j + 1) & 3) * 16) * DM + col0);
#pragma unroll
            for (int n = 0; n < 2; ++n) {
                const f32x4 v = acc[ai][0][m][n] + (n ? bv1 : bv0), g = acc[ai][1][m][n] + (n ? bg1 : bg0);
                const unsigned w0 = n ? cur.z : cur.x, w1 = n ? cur.w : cur.y; o[n] = (f32x4){bflo(w0), bfhi(w0), bflo(w1), bfhi(w1)};
                o[n][0] += v[0] * fast_sigmoid(g[0]); o[n][1] += v[1] * fast_sigmoid(g[1]); o[n][2] += v[2] * fast_sigmoid(g[2]); o[n][3] += v[3] * fast_sigmoid(g[3]);
                ss += (o[n][0] * o[n][0] + o[n][1] * o[n][1]) + (o[n][2] * o[n][2] + o[n][3] * o[n][3]); }
            { u32x4 w; w.x = pk2(o[0][0], o[0][1]); w.y = pk2(o[0][2], o[0][3]); w.z = pk2(o[1][0], o[1][1]); w.w = pk2(o[1][2], o[1][3]); *(u32x4*)(xb + off) = w; }
            ss += __shfl_xor(ss, 16); ss += __shfl_xor(ss, 32); if (fq == 0) rsq[(size_t)row * 64 + u.pn * 4 + wc] = ss;
            cur = nxt;
            asm volatile("" ::: "memory"); }
    }
};

struct EpiConv {
    unsigned char* ws; const float* cw; const float* cb; int stage; int np4; LAS unsigned char* lds;
    __device__ __forceinline__ void operator()(const f32x4 (&acc)[2][2][4][2], const Unit& u, int wr, int wc, int fr, int fq) const {
        bf16_t* act = (bf16_t*)(ws + WS_ACT); float* halo = (float*)(ws + WS_UP); const float* rsq = (const float*)(ws + WS_RSQ) + (size_t)stage * MTOK * 64;
        LAS float* ct = (LAS float*)(lds + 131072);
        const int g8 = (wr * 16 + fr) * 8, f0 = u.pn * HALF + wc * 32 + 8 * fq, pc0 = u.pn * BM + wc * 32 + 8 * fq;
        LAS float* wt = (LAS float*)(lds + 132096);
        f32x4 pw[8], pw2[8];
        if (u.seq == 0) {
            pw[0] = *(const f32x4*)(cw + f0); pw[1] = *(const f32x4*)(cw + DFF2 + f0); pw[2] = *(const f32x4*)(cw + 2 * DFF2 + f0); pw[3] = *(const f32x4*)(cb + f0);
            pw[4] = *(const f32x4*)(cw + DFF + f0); pw[5] = *(const f32x4*)(cw + DFF2 + DFF + f0); pw[6] = *(const f32x4*)(cw + 2 * DFF2 + DFF + f0); pw[7] = *(const f32x4*)(cb + DFF + f0);
            pw2[0] = *(const f32x4*)(cw + f0 + 4); pw2[1] = *(const f32x4*)(cw + DFF2 + f0 + 4); pw2[2] = *(const f32x4*)(cw + 2 * DFF2 + f0 + 4); pw2[3] = *(const f32x4*)(cb + f0 + 4);
            pw2[4] = *(const f32x4*)(cw + DFF + f0 + 4); pw2[5] = *(const f32x4*)(cw + DFF2 + DFF + f0 + 4); pw2[6] = *(const f32x4*)(cw + 2 * DFF2 + DFF + f0 + 4); pw2[7] = *(const f32x4*)(cb + DFF + f0 + 4);
        } else {
            const LAS float* wsrc = wt + (u.seq & 1) * 1024 + wc * 32 + 8 * fq;
#pragma unroll
            for (int a = 0; a < 8; ++a) { pw[a] = *(const LAS f32x4*)(wsrc + a * 128); pw2[a] = *(const LAS f32x4*)(wsrc + a * 128 + 4); }
        }
        if (u.next_pn >= 0 && wr == 0) {
            const int lane_ = fq * 16 + fr;
            const float* p0 = (wc == 0) ? cw : (wc == 1) ? cw + 2 * DFF2 : (wc == 2) ? cw + DFF : cw + 2 * DFF2 + DFF;
            const float* p1 = (wc == 0) ? cw + DFF2 : (wc == 1) ? cb : (wc == 2) ? cw + DFF2 + DFF : cb + DFF;
            const float* src = ((lane_ >> 5) ? p1 : p0) + u.next_pn * HALF + (lane_ & 31) * 4;
            __builtin_amdgcn_global_load_lds((const unsigned*)src, (LAS unsigned*)(lds + 132096 + ((u.seq + 1) & 1) * 4096 + wc * 1024), 16, 0, 0);
        }
        if (!u.same_pm) { const int t = (wr * 4 + wc) * 64 + fq * 16 + fr;
          if (t < 256) ct[t] = rstd_of(row_ssq(rsq, u.pm * BM + t, np4));
          asm volatile("s_waitcnt lgkmcnt(0)\n\ts_barrier" ::: "memory"); }
        float rs[8];
        { const f32x4 r0 = *(const LAS f32x4*)(ct + g8), r1 = *(const LAS f32x4*)(ct + g8 + 4);
#pragma unroll
          for (int e = 0; e < 4; ++e) { rs[e] = r0[e]; rs[4 + e] = r1[e]; } }
        float* hrow = halo + (size_t)((u.pm * 2 + wr) * 4) * DFF2 + pc0;
        bf16_t* arow = act + (size_t)(u.pm * BM + g8) * DFF + f0;
#pragma unroll
        for (int n = 0; n < 2; ++n) {
            const int f = f0 + 4 * n;
            f32x4 wv0, wv1, wv2, bvv, wg0, wg1, wg2, bgg;
            if (n == 0) { wv0 = pw[0]; wv1 = pw[1]; wv2 = pw[2]; bvv = pw[3]; wg0 = pw[4]; wg1 = pw[5]; wg2 = pw[6]; bgg = pw[7]; }
            else { wv0 = pw2[0]; wv1 = pw2[1]; wv2 = pw2[2]; bvv = pw2[3]; wg0 = pw2[4]; wg1 = pw2[5]; wg2 = pw2[6]; bgg = pw2[7]; }
            const f32x4 v6 = acc[1][0][2][n] * rs[6], v7 = acc[1][0][3][n] * rs[7], g6 = acc[1][1][2][n] * rs[6], g7 = acc[1][1][3][n] * rs[7];
            f32x4 av2, av1, ag2, ag1;
#pragma unroll
            for (int e = 0; e < 4; ++e) { av2[e] = __shfl_up(v6[e], 1, 16); av1[e] = __shfl_up(v7[e], 1, 16); ag2[e] = __shfl_up(g6[e], 1, 16); ag1[e] = __shfl_up(g7[e], 1, 16); }
            if (fr == 15) { *(f32x4*)(hrow + 2 * DFF2 + 4 * n) = v6; *(f32x4*)(hrow + 2 * DFF2 + HALF + 4 * n) = g6; *(f32x4*)(hrow + 3 * DFF2 + 4 * n) = v7; *(f32x4*)(hrow + 3 * DFF2 + HALF + 4 * n) = g7; }
#pragma unroll
            for (int j = 0; j < 8; ++j) {
                const f32x4 cv_ = acc[j >> 2][0][j & 3][n] * rs[j], cg_ = acc[j >> 2][1][j & 3][n] * rs[j];
                if (j < 2 && fr == 0) { *(f32x4*)(hrow + j * DFF2 + 4 * n) = cv_; *(f32x4*)(hrow + j * DFF2 + HALF + 4 * n) = cg_; }
                const f32x4 cv = bvv + wv0 * av2 + wv1 * av1 + wv2 * cv_, cg = bgg + wg0 * ag2 + wg1 * ag1 + wg2 * cg_;
                f32x4 o;
#pragma unroll
                for (int e = 0; e < 4; ++e) o[e] = cg[e] * fast_sigmoid(cg[e]) * cv[e];
                u32x2 w; w.x = pk2(o[0], o[1]); w.y = pk2(o[2], o[3]);
                if (!(j < 2 && fr == 0)) *(u32x2*)(arow + (size_t)j * DFF + 4 * n) = w;
                av2 = av1; av1 = cv_; ag2 = ag1; ag1 = cg_;
            }
        }
    }
};

template <int K, int LDA, int LDB, int KGRP, bool APERM, class Epi>
__device__ __forceinline__ void gemm_phase(LAS unsigned char* lds, const Gemm g, const StaticOrder& S, const Epi& E, const int tid) {
    const int wid = __builtin_amdgcn_readfirstlane(tid >> 6), lane = tid & 63, wr = wid >> 2, wc = wid & 3, fr = lane & 15, fq = lane >> 4;
    constexpr int nt = K / BK;
    unsigned voffA[2], voffB[2];
#pragma unroll
    for (int i = 0; i < 2; ++i) { int R, C; stage_rc(tid * 16 + i * 8192, R, C); const int Rb = (R & ~31) + perm32(R & 31);
        const int Ra = APERM ? (((R >> 6) * 16 + (R & 15)) * 8 + ((R >> 4) & 3)) : R;
        voffA[i] = (unsigned)(Ra * LDA + C) * 2u; voffB[i] = (unsigned)(Rb * LDB + C) * 2u; }
    constexpr size_t kstep = (size_t)(BK * 2);
    constexpr size_t hstepA = APERM ? (size_t)4 * LDA * 2 : (size_t)HALF * LDA * 2, hstepB = (size_t)HALF * LDB * 2;
    constexpr size_t tstepA = (size_t)BM * LDA * 2, tstepB = 2 * hstepB;
    const unsigned ldsw = (unsigned)wid * 1024u;
    const int aoff = lds_byte(wr * 64 + fr, fq * 8), boff = lds_byte(wc * 32 + fr, fq * 8);
#define PG8_SA(b, h) (((b) * 2 + (h)) * HTB)
#define PG8_SB(b, h) ((4 + (b) * 2 + (h)) * HTB)
#define PG8_STAGE(bufoff, gbase, voff) do { _Pragma("unroll") for (int _i = 0; _i < 2; ++_i) \
        __builtin_amdgcn_global_load_lds((const unsigned*)((const char*)(gbase) + (voff)[_i]), (LAS unsigned*)(lds + (bufoff) + ldsw + _i * 8192), 16, 0, 0); } while (0)
#define PG8_LDA(dst, b, h) do { _Pragma("unroll") for (int m = 0; m < 4; ++m) _Pragma("unroll") for (int k = 0; k < 2; ++k) dst[m][k] = *(const LAS bf16x8*)(lds + PG8_SA(b, h) + aoff + m * 2048 + k * 1024); } while (0)
#define PG8_LDB(dst, b, h) do { _Pragma("unroll") for (int n = 0; n < 2; ++n) _Pragma("unroll") for (int k = 0; k < 2; ++k) dst[n][k] = *(const LAS bf16x8*)(lds + PG8_SB(b, h) + boff + n * 2048 + k * 1024); } while (0)
#define PG8_MMA(ai, bj, At, Bt) do { __builtin_amdgcn_s_setprio(1); _Pragma("unroll") for (int m = 0; m < 4; ++m) _Pragma("unroll") for (int n = 0; n < 2; ++n) _Pragma("unroll") for (int k = 0; k < 2; ++k) \
        acc[ai][bj][m][n] = __builtin_amdgcn_mfma_f32_16x16x32_bf16(Bt[n][k], At[m][k], acc[ai][bj][m][n], 0, 0, 0); __builtin_amdgcn_s_setprio(0); } while (0)
#define PG8_WAIT_V(n) asm volatile("s_waitcnt vmcnt(" #n ")" ::: "memory")
#define PG8_WAIT_L(n) asm volatile("s_waitcnt lgkmcnt(" #n ")" ::: "memory")
#define PG8_BAR __builtin_amdgcn_s_barrier()
#define PG8_SCHED __builtin_amdgcn_sched_barrier(0)
#define PG8_UA(u) ((const char*)g.A + (size_t)(u).pm * tstepA + (KGRP ? (size_t)((u).pn / (KGRP ? KGRP : 1)) * (size_t)K * 2 : (size_t)0))
#define PG8_UB(u) ((const char*)g.Bt + (size_t)(u).pn * tstepB)
    Unit cur, nxt; int ui = 0;
    if (!S.next(0, cur)) return;
    cur.same_pm = 0; cur.same_pn = 0; cur.seq = 0; cur.next_pn = -1;
    f32x4 acc[2][2][4][2];
#pragma unroll
    for (int a = 0; a < 2; ++a)
#pragma unroll
        for (int b = 0; b < 2; ++b)
#pragma unroll
            for (int m = 0; m < 4; ++m)
#pragma unroll
                for (int n = 0; n < 2; ++n) acc[a][b][m][n] = (f32x4){0.f, 0.f, 0.f, 0.f};
    bf16x8 At[4][2], B0[2][2], B1[2][2];
    const char* cA = PG8_UA(cur); const char* cB = PG8_UB(cur);
    PG8_STAGE(PG8_SB(0, 0), cB, voffB); PG8_STAGE(PG8_SB(0, 1), cB + hstepB, voffB); PG8_STAGE(PG8_SA(0, 0), cA, voffA); PG8_STAGE(PG8_SA(0, 1), cA + hstepA, voffA);
    if (wr == 1) PG8_BAR;
    PG8_WAIT_V(2); PG8_BAR;
    PG8_STAGE(PG8_SB(1, 0), cB + kstep, voffB); PG8_STAGE(PG8_SA(1, 0), cA + kstep, voffA); PG8_STAGE(PG8_SB(1, 1), cB + hstepB + kstep, voffB);
    PG8_WAIT_V(6); PG8_BAR;
    for (;;) {
        const bool has_next = S.next(ui + 1, nxt);
        nxt.same_pm = (has_next && nxt.pm == cur.pm) ? 1 : 0; nxt.same_pn = (has_next && nxt.pn == cur.pn) ? 1 : 0; nxt.seq = ui + 1; nxt.next_pn = -1; cur.next_pn = has_next ? nxt.pn : -1;
        const char* nA = has_next ? PG8_UA(nxt) : cA; const char* nB = has_next ? PG8_UB(nxt) : cB;
        for (int t = 0; t < nt; t += 2) {
            const bool last = (t == nt - 2);
            const char* a1 = cA + (size_t)(t + 1) * kstep;
            const char* a2 = last ? nA : cA + (size_t)(t + 2) * kstep; const char* b2 = last ? nB : cB + (size_t)(t + 2) * kstep;
            const char* a3 = a2 + kstep; const char* b3 = b2 + kstep;
            PG8_LDB(B0, 0, 0); PG8_LDB(B1, 0, 1); PG8_SCHED; PG8_LDA(At, 0, 0); PG8_STAGE(PG8_SA(1, 1), a1 + hstepA, voffA);
            PG8_WAIT_V(8); PG8_WAIT_L(0); PG8_BAR; PG8_MMA(0, 0, At, B0); PG8_MMA(0, 1, At, B1); PG8_BAR; PG8_SCHED;
            PG8_LDA(At, 0, 1); PG8_STAGE(PG8_SB(0, 0), b2, voffB); PG8_STAGE(PG8_SB(0, 1), b2 + hstepB, voffB); PG8_STAGE(PG8_SA(0, 0), a2, voffA);
            PG8_WAIT_V(8); PG8_WAIT_L(0); PG8_BAR; PG8_MMA(1, 0, At, B0); PG8_MMA(1, 1, At, B1); PG8_BAR; PG8_SCHED;
            PG8_LDB(B0, 1, 0); PG8_LDB(B1, 1, 1); PG8_SCHED; PG8_LDA(At, 1, 0); PG8_STAGE(PG8_SA(0, 1), a2 + hstepA, voffA);
            PG8_WAIT_V(8); PG8_WAIT_L(0); PG8_BAR; PG8_MMA(0, 0, At, B0); PG8_MMA(0, 1, At, B1); PG8_BAR; PG8_SCHED;
            PG8_LDA(At, 1, 1); PG8_STAGE(PG8_SB(1, 0), b3, voffB); PG8_STAGE(PG8_SB(1, 1), b3 + hstepB, voffB); PG8_STAGE(PG8_SA(1, 0), a3, voffA);
            PG8_WAIT_V(8); PG8_WAIT_L(0); PG8_BAR; PG8_MMA(1, 0, At, B0); PG8_MMA(1, 1, At, B1); PG8_BAR; PG8_SCHED;
        }
        if (wr == 0) PG8_BAR;
        E(acc, cur, wr, wc, fr, fq);
        if (!has_next) break;
#pragma unroll
        for (int a = 0; a < 2; ++a)
#pragma unroll
            for (int b = 0; b < 2; ++b)
#pragma unroll
                for (int m = 0; m < 4; ++m)
#pragma unroll
                    for (int n = 0; n < 2; ++n) acc[a][b][m][n] = (f32x4){0.f, 0.f, 0.f, 0.f};
        cur = nxt; cA = nA; cB = nB; ++ui;
        if (wr == 1) PG8_BAR;
    }
    PG8_WAIT_V(0);
    PG8_BAR;
#undef PG8_SA
#undef PG8_SB
#undef PG8_STAGE
#undef PG8_LDA
#undef PG8_LDB
#undef PG8_MMA
#undef PG8_WAIT_V
#undef PG8_WAIT_L
#undef PG8_BAR
#undef PG8_SCHED
#undef PG8_UA
#undef PG8_UB
}
}

__device__ __forceinline__ void tr_item(const float* __restrict__ W, int K, int N, bf16_t* __restrict__ WT, int k0, int n0, int drow0, const float* gain, LAS float* scr, int lane) {
    f32x4 v[16];
    const int kq_ = lane >> 4, nn = (lane & 15) * 4;
#pragma unroll
    for (int i = 0; i < 16; ++i) v[i] = __builtin_nontemporal_load((const f32x4*)(W + (size_t)(k0 + 4 * i + kq_) * N + n0 + nn));
#pragma unroll
    for (int i = 0; i < 16; ++i) { const int kk = 4 * i + kq_; f32x4 t = v[i];
        if (gain) t = t * gain[k0 + kk];
        LAS float* s = scr + kk * 65 + nn; s[0] = t[0]; s[1] = t[1]; s[2] = t[2]; s[3] = t[3]; }
    asm volatile("s_waitcnt lgkmcnt(0)" ::: "memory");
    const int c = lane & 7;
#pragma unroll
    for (int j = 0; j < 8; ++j) { const int n = (lane >> 3) + 8 * j; const LAS float* s = scr + (8 * c) * 65 + n;
        u32x4 o; o.x = pk2(s[0 * 65], s[1 * 65]); o.y = pk2(s[2 * 65], s[3 * 65]); o.z = pk2(s[4 * 65], s[5 * 65]); o.w = pk2(s[6 * 65], s[7 * 65]);
        *(u32x4*)(WT + (size_t)(drow0 + n) * K + k0 + 8 * c) = o; }
    asm volatile("s_waitcnt lgkmcnt(0)" ::: "memory");
}
__device__ __forceinline__ int pair_row(int n0, int H) { const int gsel = n0 >= H ? 1 : 0, nn = n0 - gsel * H; return (nn >> 7) * 256 + gsel * 128 + (nn & 127); }
__device__ __forceinline__ bool tr_matrix(int& it, const float* W, int K, int N, bf16_t* WT, int drow_base, int pairH, const float* gain, LAS float* scr, int lane) {
    const int nb = N / 64, cnt = (K / 64) * nb;
    if (it >= cnt) { it -= cnt; return false; }
    const int kb = it / nb, n0 = (it % nb) * 64;
    tr_item(W, K, N, WT, kb * 64, n0, drow_base + (pairH ? pair_row(n0, pairH) : n0), gain, scr, lane);
    return true;
}

__device__ __forceinline__ void norm_row(const float* __restrict__ xrow, const float* __restrict__ g, bf16_t* __restrict__ orow, int lane) {
    f32x4 v[8]; float s = 0.f;
#pragma unroll
    for (int j = 0; j < 8; ++j) { v[j] = ((const f32x4*)xrow)[lane + 64 * j]; s += (v[j][0] * v[j][0] + v[j][1] * v[j][1]) + (v[j][2] * v[j][2] + v[j][3] * v[j][3]); }
    const float rstd = 1.0f / sqrtf(wave_sum(s) * (1.0f / DM) + RMS_EPS);
#pragma unroll
    for (int j = 0; j < 8; ++j) { const f32x4 gv = ((const f32x4*)g)[lane + 64 * j]; const f32x4 o = v[j] * rstd * gv;
        u32x2 w; w.x = pk2(o[0], o[1]); w.y = pk2(o[2], o[3]); ((u32x2*)orow)[lane + 64 * j] = w; }
}
__device__ __forceinline__ void norm_phase(const float* x, const float* g, bf16_t* hn, int gw, int ngw, int lane) {
    for (int m = gw; m < MTOK; m += ngw) norm_row(x + (size_t)m * DM, g, hn + (size_t)m * DM, lane);
}

__device__ __forceinline__ f32x4 ldx4(const float* x, const bf16_t* x16, size_t idx) {
    if (x16) { const u32x2 w = *(const u32x2*)(x16 + idx); return (f32x4){bflo(w.x), bfhi(w.x), bflo(w.y), bfhi(w.y)}; }
    return *(const f32x4*)(x + idx);
}
__device__ __forceinline__ void pool_phase(const float* __restrict__ x, const bf16_t* __restrict__ x16, const float* __restrict__ g, const float* rsq, bf16_t* __restrict__ pooled, LAS unsigned char* lds, int tid, int wid, int lane, int bid) {
    LAS float* rs = (LAS float*)lds;
    for (int chunk = bid; chunk < MTOK / 32; chunk += gridDim.x) {
        const int t0 = chunk * 32, bstart = (t0 / SEQ) * SEQ;
        for (int i = wid; i < 47; i += NWAVE) { const int r = t0 - 15 + i; float val = 0.f;
            if (r >= bstart && rsq) val = rstd_of(wave_sum(lane < 32 ? rsq[(size_t)r * 64 + lane] : 0.f));
            else if (r >= bstart) { float s = 0.f; const f32x4* xr = (const f32x4*)(x + (size_t)r * DM);
#pragma unroll
                for (int j = 0; j < 8; ++j) { const f32x4 v = xr[lane + 64 * j]; s += (v[0] * v[0] + v[1] * v[1]) + (v[2] * v[2] + v[3] * v[3]); }
                val = 1.0f / sqrtf(wave_sum(s) * (1.0f / DM) + RMS_EPS); }
            if (lane == 0) rs[i] = val; }
        __syncthreads();
        const int c = tid * 4, w = 2 << (c >> 9);
        const f32x4 gv = *(const f32x4*)(g + c);
        f32x4 S = {0.f, 0.f, 0.f, 0.f};
        for (int j = 1; j < w; ++j) { const int r = t0 - j; if (r >= bstart) S += ldx4(x, x16, (size_t)r * DM + c) * rs[15 - j]; }
        for (int tt = 0; tt < 32; ++tt) { const int r = t0 + tt;
            const f32x4 h = ldx4(x, x16, (size_t)r * DM + c) * rs[15 + tt];
            S += h;
            const int tin = r - bstart; const float inv = 1.0f / (float)(tin + 1 < w ? tin + 1 : w);
            const f32x4 p = (S * inv - h) * gv;
            u32x2 o; o.x = pk2(p[0], p[1]); o.y = pk2(p[2], p[3]); *(u32x2*)(pooled + (size_t)r * DM + c) = o;
            const int ro = r - w + 1; if (ro >= bstart) S -= ldx4(x, x16, (size_t)ro * DM + c) * rs[ro - (t0 - 15)]; }
        __syncthreads();
    }
}

__device__ __forceinline__ void convfix_phase(const float* __restrict__ halo, const float* __restrict__ cw, const float* __restrict__ cb, bf16_t* __restrict__ act, int gtid, int ngt) {
    constexpr int NQ = DFF / 4, NCHUNK = MTOK / 128;
    for (int item = gtid; item < NCHUNK * 2 * NQ; item += ngt) {
        const int c = item / (2 * NQ), r = (item / NQ) & 1, f = (item % NQ) * 4, vcol = (f >> 7) * 256 + (f & 127);
        const bool first = ((c * 128) % SEQ) == 0;
        const float* hc = halo + (size_t)(c * 4) * DFF2 + vcol; const float* hp = hc - (size_t)4 * DFF2;
        const f32x4 z = {0.f, 0.f, 0.f, 0.f};
        const f32x4 v0 = *(const f32x4*)(hc + (size_t)r * DFF2), g0 = *(const f32x4*)(hc + (size_t)r * DFF2 + 128);
        f32x4 v1, g1, v2, g2;
        if (r == 1) { v1 = *(const f32x4*)(hc); g1 = *(const f32x4*)(hc + 128); if (first) { v2 = z; g2 = z; } else { v2 = *(const f32x4*)(hp + (size_t)3 * DFF2); g2 = *(const f32x4*)(hp + (size_t)3 * DFF2 + 128); } }
        else if (first) { v1 = z; g1 = z; v2 = z; g2 = z; }
        else { v1 = *(const f32x4*)(hp + (size_t)3 * DFF2); g1 = *(const f32x4*)(hp + (size_t)3 * DFF2 + 128); v2 = *(const f32x4*)(hp + (size_t)2 * DFF2); g2 = *(const f32x4*)(hp + (size_t)2 * DFF2 + 128); }
        const f32x4 cv = *(const f32x4*)(cb + f) + *(const f32x4*)(cw + f) * v2 + *(const f32x4*)(cw + DFF2 + f) * v1 + *(const f32x4*)(cw + 2 * DFF2 + f) * v0;
        const f32x4 cg = *(const f32x4*)(cb + DFF + f) + *(const f32x4*)(cw + DFF + f) * g2 + *(const f32x4*)(cw + DFF2 + DFF + f) * g1 + *(const f32x4*)(cw + 2 * DFF2 + DFF + f) * g0;
        u32x2 w; w.x = pk2(cg[0] * fast_sigmoid(cg[0]) * cv[0], cg[1] * fast_sigmoid(cg[1]) * cv[1]); w.y = pk2(cg[2] * fast_sigmoid(cg[2]) * cv[2], cg[3] * fast_sigmoid(cg[3]) * cv[3]);
        *(u32x2*)(act + (size_t)(c * 128 + r) * DFF + f) = w;
    }
}

__device__ __forceinline__ void qknorm_phase(bf16_t* __restrict__ qk, const float* __restrict__ qg, const float* __restrict__ kg, int gw, int ngw, int lane) {
    const float QS = 1.4426950408889634f * 0.08838834764831845f;
    for (int it = gw; it < MTOK * 2; it += ngw) {
        const int row = it >> 1, part = it & 1;
        bf16_t* p = qk + (size_t)row * 4096 + part * 2048;
        const float* gg = part ? kg : qg; const float sc = part ? 1.0f : QS;
#pragma unroll
        for (int j = 0; j < 4; ++j) {
            const int c = lane + 64 * j;
            const u32x4 w = *(const u32x4*)(p + c * 8);
            float v[8];
#pragma unroll
            for (int q = 0; q < 4; ++q) { v[2 * q] = bflo(w[q]); v[2 * q + 1] = bfhi(w[q]); }
            float s = 0.f;
#pragma unroll
            for (int e = 0; e < 8; ++e) s += v[e] * v[e];
            s += __shfl_xor(s, 1); s += __shfl_xor(s, 2); s += __shfl_xor(s, 4); s += __shfl_xor(s, 8);
            const float rstd = sc / sqrtf(s * (1.0f / HD) + RMS_EPS);
            const int d0 = (c & 15) * 8;
            const f32x4 ga = *(const f32x4*)(gg + d0), gb = *(const f32x4*)(gg + d0 + 4);
            u32x4 o; o.x = pk2(v[0] * rstd * ga[0], v[1] * rstd * ga[1]); o.y = pk2(v[2] * rstd * ga[2], v[3] * rstd * ga[3]);
            o.z = pk2(v[4] * rstd * gb[0], v[5] * rstd * gb[1]); o.w = pk2(v[6] * rstd * gb[2], v[7] * rstd * gb[3]);
            *(u32x4*)(p + c * 8) = o;
        }
    }
}

constexpr int AK_ROWB = 272, AV_ROWB = 144, AK_BUF = 64 * AK_ROWB, AV_BUF = 128 * AV_ROWB;
constexpr float ATT_DONE_LOG2 = 60.0f;
__device__ __forceinline__ u32x4 knorm8(u32x4 w, const f32x4 ga, const f32x4 gb) {
    float v[8];
#pragma unroll
    for (int q = 0; q < 4; ++q) { v[2 * q] = bflo(w[q]); v[2 * q + 1] = bfhi(w[q]); }
    float ss = 0.f;
#pragma unroll
    for (int e = 0; e < 8; ++e) ss += v[e] * v[e];
    ss += __shfl_xor(ss, 1); ss += __shfl_xor(ss, 2); ss += __shfl_xor(ss, 4); ss += __shfl_xor(ss, 8);
    const float r = __builtin_amdgcn_rsqf(ss * (1.0f / HD) + RMS_EPS);
    u32x4 o; o.x = pk2(v[0] * r * ga[0], v[1] * r * ga[1]); o.y = pk2(v[2] * r * ga[2], v[3] * r * ga[3]); o.z = pk2(v[4] * r * gb[0], v[5] * r * gb[1]); o.w = pk2(v[6] * r * gb[2], v[7] * r * gb[3]);
    return o;
}
__device__ __forceinline__ void attn_unit(int b, int h, int qb, const bf16_t* __restrict__ QK, const bf16_t* __restrict__ VT, bf16_t* __restrict__ O, const float* __restrict__ qg, const float* __restrict__ kg,
                                          LAS unsigned char* lds, int tid, int wid, int lane) {
    const int r32 = lane & 31, hi = lane >> 5;
    const int q0 = qb * 256, NT = (q0 + 256) / 64;
    LAS unsigned char* Kb = lds; LAS unsigned char* Vb = lds + 2 * AK_BUF;
    LAS unsigned* flags = (LAS unsigned*)(lds + 2 * AK_BUF + 2 * AV_BUF);
    const int kc0 = tid, kc1 = tid + 512;
    const bf16_t* kg0 = QK + (size_t)(b * SEQ + (kc0 >> 4)) * 4096 + 2048 + h * HD + (kc0 & 15) * 8;
    const bf16_t* kg1 = QK + (size_t)(b * SEQ + (kc1 >> 4)) * 4096 + 2048 + h * HD + (kc1 & 15) * 8;
    const bf16_t* vg0 = VT + (size_t)(h * HD + (kc0 >> 3)) * MTOK + b * SEQ + (kc0 & 7) * 8;
    const bf16_t* vg1 = VT + (size_t)(h * HD + (kc1 >> 3)) * MTOK + b * SEQ + (kc1 & 7) * 8;
    const int kl0 = (kc0 >> 4) * AK_ROWB + (kc0 & 15) * 16, kl1 = (kc1 >> 4) * AK_ROWB + (kc1 & 15) * 16;
    const int vl0 = (kc0 >> 3) * AV_ROWB + (kc0 & 7) * 16, vl1 = (kc1 >> 3) * AV_ROWB + (kc1 & 7) * 16;
    const f32x4 kga = *(const f32x4*)(kg + (tid & 15) * 8), kgb = *(const f32x4*)(kg + (tid & 15) * 8 + 4);
    const int tq = q0 + wid * 32 + r32;
    bf16x8 qr[8];
    { const bf16_t* qp = QK + (size_t)(b * SEQ + tq) * 4096 + h * HD + hi * 8;
      u32x4 raw[8]; float ss = 0.f;
#pragma unroll
      for (int ks = 0; ks < 8; ++ks) { raw[ks] = *(const u32x4*)(qp + ks * 16);
#pragma unroll
          for (int q = 0; q < 4; ++q) { const float a = bflo(raw[ks][q]), c = bfhi(raw[ks][q]); ss += a * a + c * c; } }
      ss += __shfl_xor(ss, 32);
      const float r = __builtin_amdgcn_rsqf(ss * (1.0f / HD) + RMS_EPS) * (1.4426950408889634f * 0.08838834764831845f);
#pragma unroll
      for (int ks = 0; ks < 8; ++ks) { const f32x4 ga = *(const f32x4*)(qg + ks * 16 + hi * 8), gb = *(const f32x4*)(qg + ks * 16 + hi * 8 + 4); u32x4 o;
          o.x = pk2(bflo(raw[ks][0]) * r * ga[0], bfhi(raw[ks][0]) * r * ga[1]); o.y = pk2(bflo(raw[ks][1]) * r * ga[2], bfhi(raw[ks][1]) * r * ga[3]);
          o.z = pk2(bflo(raw[ks][2]) * r * gb[0], bfhi(raw[ks][2]) * r * gb[1]); o.w = pk2(bflo(raw[ks][3]) * r * gb[2], bfhi(raw[ks][3]) * r * gb[3]);
          qr[ks] = __builtin_bit_cast(bf16x8, o); } }
    const int krow = 16 * ((r32 >> 2) & 1) + (r32 & 3) + 4 * (r32 >> 3);
    const int kfo = krow * AK_ROWB + hi * 16, vfo = r32 * AV_ROWB + hi * 32;
    f32x16 o[4];
#pragma unroll
    for (int d = 0; d < 4; ++d)
#pragma unroll
        for (int r = 0; r < 16; ++r) o[d][r] = 0.f;
    float R = 0.f; bool wdone = false;
    u32x4 sk0, sk1, sv0, sv1;
    { const int kt = NT - 1; sk0 = *(const u32x4*)(kg0 + (size_t)kt * 64 * 4096); sk1 = *(const u32x4*)(kg1 + (size_t)kt * 64 * 4096); sv0 = *(const u32x4*)(vg0 + kt * 64); sv1 = *(const u32x4*)(vg1 + kt * 64); }
    *(LAS u32x4*)(Kb + kl0) = knorm8(sk0, kga, kgb); *(LAS u32x4*)(Kb + kl1) = knorm8(sk1, kga, kgb); *(LAS u32x4*)(Vb + vl0) = sv0; *(LAS u32x4*)(Vb + vl1) = sv1;
    __syncthreads();
    int buf = 0;
    for (int kt = NT - 1; kt >= 0; --kt) {
        if (kt > 0) { const int kn = kt - 1; sk0 = *(const u32x4*)(kg0 + (size_t)kn * 64 * 4096); sk1 = *(const u32x4*)(kg1 + (size_t)kn * 64 * 4096); sv0 = *(const u32x4*)(vg0 + kn * 64); sv1 = *(const u32x4*)(vg1 + kn * 64); }
        if (!wdone && kt * 64 < q0 + wid * 32 + 31) {
            const LAS unsigned char* kb_ = Kb + buf * AK_BUF + kfo; const LAS unsigned char* vb_ = Vb + buf * AV_BUF + vfo;
            f32x16 p[2];
#pragma unroll
            for (int kb = 0; kb < 2; ++kb) {
#pragma unroll
                for (int r = 0; r < 16; ++r) p[kb][r] = 0.f;
#pragma unroll
                for (int ks = 0; ks < 8; ++ks) { const bf16x8 a = *(const LAS bf16x8*)(kb_ + kb * 32 * AK_ROWB + ks * 32); p[kb] = __builtin_amdgcn_mfma_f32_32x32x16_bf16(a, qr[ks], p[kb], 0, 0, 0); }
            }
            const bool needmask = (kt * 64 + 63 >= q0 + wid * 32);
            float T[2];
#pragma unroll
            for (int kb = 1; kb >= 0; --kb) {
                float run = 0.f; const int s0 = kt * 64 + kb * 32 + hi * 16;
#pragma unroll
                for (int r = 15; r >= 0; --r) {
                    const float z = p[kb][r];
                    const float e = __builtin_amdgcn_exp2f(z);
                    float sp = __builtin_amdgcn_logf(1.0f + e);
                    float a = __builtin_amdgcn_exp2f(z - sp - run);
                    if (needmask && !(s0 + r < tq)) { sp = 0.f; a = 0.f; }
                    run += sp; p[kb][r] = a; }
                T[kb] = run; }
            const float T0o = __shfl_xor(T[0], 32), T1o = __shfl_xor(T[1], 32);
            const float base1 = R + (hi == 0 ? T1o : 0.f), base0 = R + T[1] + T1o + (hi == 0 ? T0o : 0.f);
            const float f0 = __builtin_amdgcn_exp2f(-base0), f1 = __builtin_amdgcn_exp2f(-base1);
            R += (T[0] + T0o) + (T[1] + T1o);
            bf16x8 pa[2][2];
#pragma unroll
            for (int kb = 0; kb < 2; ++kb) { const float f = kb ? f1 : f0;
#pragma unroll
                for (int s2 = 0; s2 < 2; ++s2) { u32x4 w;
                    w.x = pk2(p[kb][8 * s2 + 0] * f, p[kb][8 * s2 + 1] * f); w.y = pk2(p[kb][8 * s2 + 2] * f, p[kb][8 * s2 + 3] * f);
                    w.z = pk2(p[kb][8 * s2 + 4] * f, p[kb][8 * s2 + 5] * f); w.w = pk2(p[kb][8 * s2 + 6] * f, p[kb][8 * s2 + 7] * f);
                    pa[kb][s2] = __builtin_bit_cast(bf16x8, w); } }
#pragma unroll
            for (int d = 0; d < 4; ++d)
#pragma unroll
                for (int kb = 0; kb < 2; ++kb)
#pragma unroll
                    for (int s2 = 0; s2 < 2; ++s2) { const bf16x8 vb = *(const LAS bf16x8*)(vb_ + d * 32 * AV_ROWB + kb * 64 + s2 * 16); o[d] = __builtin_amdgcn_mfma_f32_32x32x16_bf16(pa[kb][s2], vb, o[d], 0, 0, 0); }
            wdone = __all(R >= ATT_DONE_LOG2) != 0;
        }
        if (lane == 0) flags[(kt & 1) * 8 + wid] = wdone ? 1u : 0u;
        if (kt > 0) { const int nb = buf ^ 1; *(LAS u32x4*)(Kb + nb * AK_BUF + kl0) = knorm8(sk0, kga, kgb); *(LAS u32x4*)(Kb + nb * AK_BUF + kl1) = knorm8(sk1, kga, kgb); *(LAS u32x4*)(Vb + nb * AV_BUF + vl0) = sv0; *(LAS u32x4*)(Vb + nb * AV_BUF + vl1) = sv1; }
        __syncthreads();
        buf ^= 1;
        { const u32x4 fa = *(const LAS u32x4*)(flags + (kt & 1) * 8), fb = *(const LAS u32x4*)(flags + (kt & 1) * 8 + 4);
          if ((fa[0] & fa[1] & fa[2] & fa[3] & fb[0] & fb[1] & fb[2] & fb[3]) != 0u) break; }
    }
    bf16_t* op = O + (size_t)(b * SEQ + q0 + wid * 32) * DM + h * HD + r32;
#pragma unroll
    for (int r = 0; r < 16; ++r) { const int qrow = (r & 3) + 8 * (r >> 2) + 4 * hi;
#pragma unroll
        for (int d = 0; d < 4; ++d) op[(size_t)qrow * DM + d * 32] = (bf16_t)(pk2(o[d][r], 0.f) & 0xffffu); }
    __syncthreads();
}
__device__ __forceinline__ void attn_phase(const bf16_t* QK, const bf16_t* VT, bf16_t* O, const float* qg, const float* kg, LAS unsigned char* lds, int tid, int wid, int lane, int bid) {
    for (int pi = bid; pi < 256; pi += gridDim.x) {
        const int bh = pi >> 2, s4 = pi & 3;
        attn_unit(bh / NHEAD, bh % NHEAD, 7 - s4, QK, VT, O, qg, kg, lds, tid, wid, lane);
        attn_unit(bh / NHEAD, bh % NHEAD, s4, QK, VT, O, qg, kg, lds, tid, wid, lane);
    }
}

__device__ __forceinline__ void sincos_2pi(float rev, float& s, float& c) {
    rev -= rintf(rev);
    const float kq = rintf(rev * 4.0f); const float a = (rev - kq * 0.25f) * 6.283185307179586f;
    const float a2 = a * a;
    const float sn = a * (1.0f + a2 * (-1.6666667e-1f + a2 * (8.3333310e-3f + a2 * (-1.98409e-4f + a2 * 2.7526e-6f))));
    const float cs = 1.0f + a2 * (-0.5f + a2 * (4.16666418e-2f + a2 * (-1.388731625e-3f + a2 * 2.443315711e-5f)));
    const int k = ((int)kq) & 3;
    s = (k == 0) ? sn : (k == 1) ? cs : (k == 2) ? -sn : -cs;
    c = (k == 0) ? cs : (k == 1) ? -sn : (k == 2) ? -cs : sn;
}
__device__ __forceinline__ void s5_disc(float lr, float li, float step, float& lbr, float& lbi, float& fr, float& fi) {
    const float mag = expf(lr * step); float sn, cs; sincos_2pi(li * step * 0.15915494309189535f, sn, cs);
    lbr = mag * cs; lbi = mag * sn;
    const float den = lr * lr + li * li;
    fr = ((lbr - 1.0f) * lr + lbi * li) / den; fi = (lbi * lr - (lbr - 1.0f) * li) / den;
}
constexpr int S5_XS_ROWB = 272, S5_XS_BUF = 65 * S5_XS_ROWB, S5_PAIR_BYTES = 2 * S5_XS_BUF;
__device__ __forceinline__ void cfma(float& orr, float& oi, float ar, float ai, float xr, float xi, float cr, float ci) {
    orr = fmaf(ar, xr, fmaf(-ai, xi, cr)); oi = fmaf(ar, xi, fmaf(ai, xr, ci));
}
__device__ __forceinline__ float other_half(float x) {
    const unsigned u = __float_as_uint(x); auto rr = __builtin_amdgcn_permlane32_swap(u, u, false, false);
    return __uint_as_float(rr[0] ^ rr[1] ^ u);
}
#define S5_BAR() asm volatile("s_waitcnt lgkmcnt(0)\n\ts_barrier" ::: "memory")
__device__ __forceinline__ void s5_phase(const bf16_t* __restrict__ HN, bf16_t* __restrict__ Y, const float* __restrict__ rsq, const float* __restrict__ gmix, const float* lam_re, const float* lam_im, const float* log_step,
                                         const float* b_re, const float* b_im, const float* c_re, const float* c_im, const float* dskip,
                                         LAS unsigned char* lds, int tid, int wid, int lane, int bid) {
    const int hf = (wid >> 1) & 1, hw = (wid & 1) + 2 * (wid >> 2), r32 = lane & 31, hi = lane >> 5, l16 = lane & 15, kq = lane >> 4;
    LAS unsigned char* XS = lds + hf * S5_PAIR_BYTES;
    LAS float* RT = (LAS float*)(lds + 2 * S5_PAIR_BYTES);
    constexpr int NC = SEQ / 64;
    for (int pr0 = bid * 2; pr0 < NB * SSM_G; pr0 += gridDim.x * 2) {
        const int pr = pr0 + hf, b = pr / SSM_G, g = pr % SSM_G;
        for (int t = tid; t < SEQ; t += NTHR) RT[t] = rstd_of(row_ssq(rsq, b * SEQ + t, 8));
        __syncthreads();
        const bf16_t* ubase = HN + (size_t)(b * SEQ) * DM + g * SSM_H;
        if (hw < 2) {
            const int p = 32 * hw + r32;
            const float step = expf(log_step[g]);
            float lbr, lbi, fr, fi; s5_disc(lam_re[g * SSM_P + p], lam_im[g * SSM_P + p], step, lbr, lbi, fr, fi);
            bf16x8 bbr, bbi;
            { const float* br = b_re + (size_t)(g * SSM_P + p) * SSM_H + hi * 8; const float* bi = b_im + (size_t)(g * SSM_P + p) * SSM_H + hi * 8;
              float vr[8], vi[8];
#pragma unroll
              for (int j = 0; j < 8; ++j) { vr[j] = fr * br[j] - fi * bi[j]; vi[j] = fr * bi[j] + fi * br[j]; }
              u32x4 w; w.x = pk2(vr[0], vr[1]); w.y = pk2(vr[2], vr[3]); w.z = pk2(vr[4], vr[5]); w.w = pk2(vr[6], vr[7]); bbr = __builtin_bit_cast(bf16x8, w);
              w.x = pk2(vi[0], vi[1]); w.y = pk2(vi[2], vi[3]); w.z = pk2(vi[4], vi[5]); w.w = pk2(vi[6], vi[7]); bbi = __builtin_bit_cast(bf16x8, w); }
            float gA[8];
#pragma unroll
            for (int j = 0; j < 8; ++j) gA[j] = gmix[g * SSM_H + hi * 8 + j];
            const float l2r = lbr * lbr - lbi * lbi, l2i = 2.0f * lbr * lbi, l3r = l2r * lbr - l2i * lbi, l3i = l2r * lbi + l2i * lbr, l4r = l2r * l2r - l2i * l2i, l4i = 2.0f * l2r * l2i;
            float xr = 0.f, xi = 0.f;
            u32x4 ua[2];
#pragma unroll
            for (int mb = 0; mb < 2; ++mb) ua[mb] = *(const u32x4*)(ubase + (size_t)(mb * 32 + r32) * DM + hi * 8);
            for (int c = 0; c <= NC; ++c) {
                if (c < NC) {
                    LAS unsigned char* xs = XS + (c & 1) * S5_XS_BUF + p * 4;
                    u32x4 un[2] = {ua[0], ua[1]};
                    if (c + 1 < NC) {
#pragma unroll
                        for (int mb = 0; mb < 2; ++mb) un[mb] = *(const u32x4*)(ubase + (size_t)((c + 1) * 64 + mb * 32 + r32) * DM + hi * 8); }
#pragma unroll
                    for (int mb = 0; mb < 2; ++mb) {
                        const float rs = RT[c * 64 + mb * 32 + r32]; u32x4 o;
#pragma unroll
                        for (int q = 0; q < 4; ++q) o[q] = pk2(bflo(ua[mb][q]) * rs * gA[2 * q], bfhi(ua[mb][q]) * rs * gA[2 * q + 1]);
                        f32x16 zr, zi;
#pragma unroll
                        for (int r = 0; r < 16; ++r) { zr[r] = 0.f; zi[r] = 0.f; }
                        zr = __builtin_amdgcn_mfma_f32_32x32x16_bf16(__builtin_bit_cast(bf16x8, o), bbr, zr, 0, 0, 0);
                        zi = __builtin_amdgcn_mfma_f32_32x32x16_bf16(__builtin_bit_cast(bf16x8, o), bbi, zi, 0, 0, 0);
#pragma unroll
                        for (int grp = 0; grp < 8; ++grp) {
                            const int r0 = 4 * (grp >> 1);
                            float c1r, c1i, fr_, fi_, er, ei;
                            cfma(c1r, c1i, lbr, lbi, zr[r0], zi[r0], zr[r0 + 1], zi[r0 + 1]);
                            cfma(fr_, fi_, lbr, lbi, c1r, c1i, zr[r0 + 2], zi[r0 + 2]);
                            cfma(er, ei, lbr, lbi, fr_, fi_, zr[r0 + 3], zi[r0 + 3]);
                            const float Xr = other_half(xr), Xi = other_half(xi);
                            float ar, ai, br_, bi_, cr, ci;
                            cfma(ar, ai, lbr, lbi, Xr, Xi, zr[r0], zi[r0]);
                            cfma(br_, bi_, l2r, l2i, Xr, Xi, c1r, c1i);
                            cfma(cr, ci, l3r, l3i, Xr, Xi, fr_, fi_);
                            cfma(xr, xi, l4r, l4i, Xr, Xi, er, ei);
                            const bool act = (hi == (grp & 1));
                            LAS unsigned char* q = xs + (act ? (mb * 32 + 4 * grp) : 64) * S5_XS_ROWB; const int st = act ? S5_XS_ROWB : 0;
                            *(LAS unsigned*)(q) = pk2(ar, ai); *(LAS unsigned*)(q + st) = pk2(br_, bi_); *(LAS unsigned*)(q + 2 * st) = pk2(cr, ci); *(LAS unsigned*)(q + 3 * st) = pk2(xr, xi);
                        }
                    }
                    ua[0] = un[0]; ua[1] = un[1];
                }
                S5_BAR();
            }
        } else {
            const int pw = hw - 2;
            bf16x8 cm[4];
#pragma unroll
            for (int ks = 0; ks < 4; ++ks) { const int p0 = (ks * 32 + kq * 8) >> 1; float v[8];
                const float* sr = c_re + (size_t)(g * SSM_H + l16) * SSM_P + p0; const float* si = c_im + (size_t)(g * SSM_H + l16) * SSM_P + p0;
#pragma unroll
                for (int j = 0; j < 4; ++j) { v[2 * j] = sr[j]; v[2 * j + 1] = -si[j]; }
                u32x4 w; w.x = pk2(v[0], v[1]); w.y = pk2(v[2], v[3]); w.z = pk2(v[4], v[5]); w.w = pk2(v[6], v[7]); cm[ks] = __builtin_bit_cast(bf16x8, w); }
            const float dsk = dskip[g * SSM_H + l16], gS = gmix[g * SSM_H + l16];
            unsigned short usn[2][4];
#pragma unroll
            for (int k2 = 0; k2 < 2; ++k2)
#pragma unroll
                for (int i = 0; i < 4; ++i) usn[k2][i] = ubase[(size_t)(16 * (2 * pw + k2) + 4 * kq + i) * DM + l16];
            for (int c = 0; c <= NC; ++c) {
                if (c > 0) {
                    const int cc = c - 1;
                    unsigned short us[2][4];
#pragma unroll
                    for (int k2 = 0; k2 < 2; ++k2)
#pragma unroll
                        for (int i = 0; i < 4; ++i) us[k2][i] = usn[k2][i];
                    if (c < NC) { const bf16_t* urow = ubase + (size_t)(c * 64) * DM;
#pragma unroll
                        for (int k2 = 0; k2 < 2; ++k2)
#pragma unroll
                            for (int i = 0; i < 4; ++i) usn[k2][i] = urow[(size_t)(16 * (2 * pw + k2) + 4 * kq + i) * DM + l16]; }
                    const LAS unsigned char* xs = XS + (cc & 1) * S5_XS_BUF;
#pragma unroll
                    for (int k2 = 0; k2 < 2; ++k2) { const int tb = 16 * (2 * pw + k2);
                        f32x4 y = {0.f, 0.f, 0.f, 0.f};
#pragma unroll
                        for (int ks = 0; ks < 4; ++ks) { const bf16x8 xa = *(const LAS bf16x8*)(xs + (tb + l16) * S5_XS_ROWB + (ks * 32 + kq * 8) * 2); y = __builtin_amdgcn_mfma_f32_16x16x32_bf16(xa, cm[ks], y, 0, 0, 0); }
#pragma unroll
                        for (int i = 0; i < 4; ++i) { const int tk = tb + 4 * kq + i; const float v = y[i] + dsk * (bf2f(us[k2][i]) * RT[cc * 64 + tk] * gS);
                            const float a2 = 1.5957691216057308f * (v + 0.044715f * v * v * v);
                            Y[(size_t)(b * SEQ + cc * 64 + tk) * DM + g * SSM_H + l16] = (bf16_t)(pk2(v * fast_sigmoid(a2), 0.f) & 0xffffu); } }
                }
                S5_BAR();
            }
        }
        __syncthreads();
    }
}

#define XB_TMO      128
#define XB_XCNT(j)  (256  + 64 * (j))
#define XB_XSUB(j)  (1280 + 64 * (j))
#define XB_XGEN(j)  (2304 + 64 * (j))
#define XB_TOP      3328
#define XB_TOPGEN   3392
#define XCD_BAR_WORDS 3456
#define XB_SPIN_CAP (1u << 22)
constexpr int CTL_QUEUE_WORD = 4096;
constexpr size_t CTL_ZERO_BYTES = (CTL_QUEUE_WORD + 64 * 4) * sizeof(unsigned);
__device__ __forceinline__ unsigned xb_ld(unsigned* p)              { return __hip_atomic_load(p, __ATOMIC_RELAXED, __HIP_MEMORY_SCOPE_AGENT); }
__device__ __forceinline__ unsigned xb_add(unsigned* p, unsigned v) { return __hip_atomic_fetch_add(p, v, __ATOMIC_RELAXED, __HIP_MEMORY_SCOPE_AGENT); }
__device__ __forceinline__ unsigned xb_xcc_id() { return (unsigned)__builtin_amdgcn_s_getreg((3 << 11) | 20) & 0xFu; }
#define XB_SPIN(cond, bar) do { unsigned _sp = 0; while (cond) { __builtin_amdgcn_s_sleep(1); \
    if ((++_sp & 255u) == 0u) { if (xb_ld(&(bar)[XB_TMO])) break; if (_sp > XB_SPIN_CAP) { atomicAdd(&(bar)[XB_TMO], 1u); break; } } } } while (0)
struct XcdBarrier { unsigned* bar; unsigned x; volatile LAS unsigned* st; };
__device__ __forceinline__ XcdBarrier xcd_barrier_post(unsigned* bar, volatile LAS unsigned* st) {
    XcdBarrier b; b.bar = bar; b.x = xb_xcc_id(); b.st = st;
    if (threadIdx.x == 0) (void)xb_add(&bar[XB_XCNT(b.x)], 1u);
    return b;
}
__device__ __forceinline__ void xcd_barrier_complete(unsigned* bar, unsigned x, unsigned& nloc, unsigned& nx) {
    const unsigned G = gridDim.x * gridDim.y * gridDim.z;
    unsigned sum, cnt, mine, sp = 0u;
    for (;;) {
        sum = 0u; cnt = 0u; mine = 0u;
#pragma unroll
        for (unsigned j = 0; j < 16; ++j) { const unsigned c = xb_ld(&bar[XB_XCNT(j)]); sum += c; cnt += (c > 0u) ? 1u : 0u; mine = (j == x) ? c : mine; }
        if (sum == G) break;
        __builtin_amdgcn_s_sleep(1);
        if ((++sp & 255u) == 0u) { if (xb_ld(&bar[XB_TMO])) break; if (sp > XB_SPIN_CAP) { atomicAdd(&bar[XB_TMO], 1u); break; } }
    }
    nloc = mine > 0u ? mine : 1u; nx = cnt > 0u ? cnt : 1u;
}
__device__ __forceinline__ void xcd_barrier(const XcdBarrier& b) {
    asm volatile("s_waitcnt vmcnt(0)" ::: "memory");
    __syncthreads();
    if (threadIdx.x == 0) {
        unsigned* bar = b.bar;
        __builtin_amdgcn_s_waitcnt(0);
        unsigned nloc = b.st[0], nx = b.st[1];
        if (nloc == 0u) { xcd_barrier_complete(bar, b.x, nloc, nx); b.st[0] = nloc; b.st[1] = nx; }
        const unsigned old = xb_add(&bar[XB_XSUB(b.x)], 1u);
        const unsigned gen = old / nloc;
        if (old + 1u == (gen + 1u) * nloc) {
            __builtin_amdgcn_fence(__ATOMIC_RELEASE, "agent");
            asm volatile("s_waitcnt vmcnt(0)" ::: "memory");
            const unsigned og = xb_add(&bar[XB_TOP], 1u);
            const unsigned tg = og / nx;
            if (og + 1u == (tg + 1u) * nx) xb_add(&bar[XB_TOPGEN], 1u);
            else XB_SPIN(xb_ld(&bar[XB_TOPGEN]) == tg, bar);
            __builtin_amdgcn_fence(__ATOMIC_ACQUIRE, "agent");
            xb_add(&bar[XB_XGEN(b.x)], 1u);
            asm volatile("s_waitcnt vmcnt(0)" ::: "memory");
        } else {
            XB_SPIN(xb_ld(&bar[XB_XGEN(b.x)]) == gen, bar);
            __builtin_amdgcn_fence(__ATOMIC_ACQUIRE, "agent");
            asm volatile("s_waitcnt vmcnt(0)" ::: "memory");
        }
    }
    __syncthreads();
}

struct Args { const float* in[24]; float* out; unsigned char* ws; int ph_lo, ph_hi; };
enum { I_X = 0, I_NMG, I_NFG, I_POOLW, I_POOLB, I_POOLS, I_QKVW, I_QG, I_KG, I_OW, I_LRE, I_LIM, I_LSTEP, I_BRE, I_BIM, I_CRE, I_CIM, I_SD, I_GLUW, I_GLUB, I_UPW, I_CONVW, I_CONVB, I_DNW };

__device__ __forceinline__ const Args* kargs();
__device__ __forceinline__ const float* IN(int i);
__device__ __forceinline__ bf16_t* WSP(size_t off);
constexpr int UP_ITEMS = 32 * 176, DN_ITEMS = 88 * 32;
__device__ __forceinline__ bool convert_up(int& it, int l, LAS float* scr, int lane) {
    return tr_matrix(it, IN(I_UPW) + (size_t)l * DM * DFF2, DM, DFF2, WSP(WS_UPW) + (size_t)l * DFF2 * DM, 0, DFF, IN(I_NFG) + (size_t)l * DM, scr, lane);
}
__device__ __forceinline__ bool convert_dn(int& it, int l, LAS float* scr, int lane) {
    return tr_matrix(it, IN(I_DNW) + (size_t)l * DFF * DM, DFF, DM, WSP(WS_DNW) + (size_t)l * DM * DFF, 0, 0, nullptr, scr, lane);
}
__device__ __forceinline__ void convert_layer(int lc, unsigned* ctr, LAS unsigned char* lds, int tid, int wid, int lane) {
    const int l = lc + 1, kind = (l < DEPTH) ? l % 3 : 0;
    const int nmix = (kind == 1) ? (32 * 96 + 32 * 32) : (kind == 2) ? (32 * 64) : 0;
    const int total = DN_ITEMS + ((l < DEPTH) ? nmix + UP_ITEMS : 0);
    LAS float* scr = (LAS float*)(lds + wid * (64 * 65 * 4));
    volatile LAS unsigned* slot = (volatile LAS unsigned*)(lds + LDS_BYTES - 8);
    for (;;) {
        if (tid == 0) *slot = __hip_atomic_fetch_add(ctr, 16u, __ATOMIC_RELAXED, __HIP_MEMORY_SCOPE_AGENT);
        __syncthreads();
        const int base = (int)*slot;
        __syncthreads();
        if (base >= total) break;
#pragma unroll 1
        for (int k = 0; k < 2; ++k) { int it = base + k * NWAVE + wid; if (it >= total) continue;
            if (convert_dn(it, lc, scr, lane)) continue;
            if (kind == 1) { if (tr_matrix(it, IN(I_QKVW), DM, 3 * DM, WSP(WS_QKVW), 0, 0, IN(I_NMG) + (size_t)l * DM, scr, lane)) continue;
                             if (tr_matrix(it, IN(I_OW), DM, DM, WSP(WS_OW), 0, 0, nullptr, scr, lane)) continue; }
            if (kind == 2) { if (tr_matrix(it, IN(I_GLUW), DM, 2 * DM, WSP(WS_GLUW), 0, DM, nullptr, scr, lane)) continue; }
            (void)convert_up(it, l, scr, lane); }
    }
}
__device__ __forceinline__ const Args* kargs() { return (const Args*)__builtin_amdgcn_kernarg_segment_ptr(); }
__device__ __forceinline__ const float* IN(int i) { int z = 0; asm volatile("" : "+s"(z)); return kargs()->in[i + z]; }
__device__ __forceinline__ float* OUTP() { int z = 0; asm volatile("" : "+s"(z)); return (&kargs()->out)[z]; }
__device__ __forceinline__ float* RSQP(int k) { int z = 0; asm volatile("" : "+s"(z)); return (float*)((&kargs()->ws)[z] + WS_RSQ) + (size_t)k * MTOK * 64; }
__device__ __forceinline__ bf16_t* WSP(size_t off) { int z = 0; asm volatile("" : "+s"(z)); return (bf16_t*)((&kargs()->ws)[z] + off); }

__global__ void __launch_bounds__(NTHR, 2) mega_fwd(Args a) {
    extern __shared__ __attribute__((aligned(16))) unsigned char lds_raw[];
    LAS unsigned char* lds = (LAS unsigned char*)lds_raw;
    cg::grid_group grid = cg::this_grid();
#define G_ ((int)gridDim.x)
#define GW_ (bid * NWAVE + wid)
#define NGW_ (G_ * NWAVE)
    const int lo = a.ph_lo, hi = a.ph_hi;
    int ph = 0;
    volatile LAS unsigned* xst = (volatile LAS unsigned*)(lds + LDS_BYTES - 16);
    if (threadIdx.x < 2) xst[threadIdx.x] = 0u;
    if (a.ph_lo < 0) grid.sync();
    (void)xcd_barrier_post((unsigned*)(a.ws + WS_CTL), xst);
#define PH_BEGIN if (ph >= lo && ph < hi) { int tid = threadIdx.x; asm volatile("" : "+v"(tid)); int bid = blockIdx.x; asm volatile("" : "+s"(bid)); const int lane = tid & 63, wid = __builtin_amdgcn_readfirstlane(tid >> 6); (void)lane; (void)wid; (void)bid;
#define PH_END   if (ph + 1 < hi) { XcdBarrier xb_; xb_.bar = (unsigned*)WSP(WS_CTL); xb_.x = xb_xcc_id(); xb_.st = xst; xcd_barrier(xb_); } } ++ph;

    PH_BEGIN
        LAS float* scr = (LAS float*)(lds + wid * (64 * 65 * 4));
        constexpr int I_POOL = 8 * 8;
        const int NIT = 8 * I_POOL + UP_ITEMS;
        for (int it0 = GW_; it0 < NIT; it0 += NGW_) {
            int it = it0; bool done = false;
            for (int m = 0; m < 8 && !done; ++m) done = tr_matrix(it, IN(I_POOLW) + (size_t)m * 512 * 512, 512, 512, WSP(WS_POOLW) + (size_t)(m >> 2) * 2048 * 512, (m & 3) * 512, 0, nullptr, scr, lane);
            if (!done) (void)convert_up(it, 0, scr, lane);
        }
        __syncthreads();
        pool_phase(IN(I_X), nullptr, IN(I_NMG), nullptr, WSP(WS_MIX), lds, tid, wid, lane, bid);
    PH_END

    for (int li = 0; li < DEPTH; ++li) {
        const int kind = li % 3, lj = li / 3;
        if (kind == 0) {
            if (li != 0) { PH_BEGIN pool_phase(nullptr, WSP(WS_HN), IN(I_NMG) + (size_t)li * DM, RSQP(2 * li - 1), WSP(WS_MIX), lds, tid, wid, lane, bid); PH_END }
            PH_BEGIN
                pg8::Gemm g{WSP(WS_MIX), WSP(WS_POOLW) + (size_t)lj * 2048 * 512}; pg8::StaticOrder S; S.init(MTOK, DM, G_, bid);
                if (li == 0) { pg8::EpiResid<0> E{IN(I_X), nullptr, IN(I_POOLB) + (size_t)lj * DM, IN(I_POOLS) + (size_t)lj * DM, WSP(WS_HN), RSQP(2 * li)}; pg8::gemm_phase<512, DM, 512, 2, false>(lds, g, S, E, tid); }
                else { pg8::EpiResid<1> E{nullptr, nullptr, IN(I_POOLB) + (size_t)lj * DM, IN(I_POOLS) + (size_t)lj * DM, WSP(WS_HN), RSQP(2 * li)}; pg8::gemm_phase<512, DM, 512, 2, false>(lds, g, S, E, tid); }
            PH_END
        } else if (kind == 1) {
            PH_BEGIN
                { pg8::Gemm g{WSP(WS_HN), WSP(WS_QKVW)}; pg8::StaticOrder S; S.init(MTOK, 2 * DM, G_, bid); pg8::EpiBf16<1> E{WSP(WS_QK), 2 * DM, RSQP(2 * li - 1), 8, lds}; pg8::gemm_phase<DM, DM, DM, 0, false>(lds, g, S, E, tid); }
                { pg8::Gemm g{WSP(WS_QKVW) + (size_t)2 * DM * DM, WSP(WS_HN)}; pg8::StaticOrder S; S.init(DM, MTOK, G_, bid); pg8::EpiBf16<2> E{WSP(WS_VT), MTOK, RSQP(2 * li - 1), 8, lds}; pg8::gemm_phase<DM, DM, DM, 0, false>(lds, g, S, E, tid); }
            PH_END
            PH_BEGIN attn_phase(WSP(WS_QK), WSP(WS_VT), WSP(WS_MIX), IN(I_QG), IN(I_KG), lds, tid, wid, lane, bid); PH_END
            PH_BEGIN
                pg8::Gemm g{WSP(WS_MIX), WSP(WS_OW)}; pg8::StaticOrder S; S.init(MTOK, DM, G_, bid);
                pg8::EpiResid<1> E{nullptr, nullptr, nullptr, nullptr, WSP(WS_HN), RSQP(2 * li)}; pg8::gemm_phase<DM, DM, DM, 0, false>(lds, g, S, E, tid);
            PH_END
        } else {
            PH_BEGIN s5_phase(WSP(WS_HN), WSP(WS_MIX), RSQP(2 * li - 1), IN(I_NMG) + (size_t)li * DM, IN(I_LRE), IN(I_LIM), IN(I_LSTEP), IN(I_BRE), IN(I_BIM), IN(I_CRE), IN(I_CIM), IN(I_SD), lds, tid, wid, lane, bid); PH_END
            PH_BEGIN
                pg8::Gemm g{WSP(WS_MIX), WSP(WS_GLUW)}; pg8::StaticOrder S; S.init(MTOK, 2 * DM, G_, bid);
                pg8::EpiGlu E{IN(I_GLUB), WSP(WS_HN), RSQP(2 * li)}; pg8::gemm_phase<DM, DM, DM, 0, false>(lds, g, S, E, tid);
            PH_END
        }
        PH_BEGIN
            pg8::Gemm g{WSP(WS_HN), WSP(WS_UPW) + (size_t)li * DFF2 * DM}; pg8::StaticOrder S; S.init(MTOK, DFF2, G_, bid);
            pg8::EpiConv E{(unsigned char*)WSP(0), IN(I_CONVW) + (size_t)li * 3 * DFF2, IN(I_CONVB) + (size_t)li * DFF2, 2 * li, (kind == 2) ? 16 : 8, lds}; pg8::gemm_phase<DM, DM, DM, 0, true>(lds, g, S, E, tid);
            convert_layer(li, (unsigned*)WSP(WS_CTL) + CTL_QUEUE_WORD + 64 * li, lds, tid, wid, lane);
        PH_END
        PH_BEGIN convfix_phase((const float*)WSP(WS_UP), IN(I_CONVW) + (size_t)li * 3 * DFF2, IN(I_CONVB) + (size_t)li * DFF2, WSP(WS_ACT), bid * NTHR + tid, G_ * NTHR); PH_END
        PH_BEGIN
            pg8::Gemm g{WSP(WS_ACT), WSP(WS_DNW) + (size_t)li * DM * DFF}; pg8::StaticOrder S; S.init(MTOK, DM, G_, bid);
            if (li < DEPTH - 1) { pg8::EpiResid<1> E{nullptr, nullptr, nullptr, nullptr, WSP(WS_HN), RSQP(2 * li + 1)}; pg8::gemm_phase<DFF, DFF, DFF, 0, false>(lds, g, S, E, tid); }
            else { pg8::EpiResid<2> E{nullptr, OUTP(), nullptr, nullptr, WSP(WS_HN), nullptr}; pg8::gemm_phase<DFF, DFF, DFF, 0, false>(lds, g, S, E, tid); }
        PH_END
    }
#undef PH_BEGIN
#undef PH_END
}
constexpr int N_PHASES = 21;

extern "C" void kernel_launch(void* const* d_in, const int* in_sizes, int n_in, void* d_out, int out_size, void* d_ws, size_t ws_size, hipStream_t stream) {
    static int grid = 0;
    if (grid == 0) {
        if (n_in != 24 || out_size != MTOK * DM || ws_size < WS_END) { fprintf(stderr, "kernel_launch: unexpected shapes (n_in %d out %d ws %zu)\n", n_in, out_size, ws_size); grid = -1; return; }
        int dev = 0, cus = 0, per_cu = 0;
        hipGetDevice(&dev); hipDeviceGetAttribute(&cus, hipDeviceAttributeMultiprocessorCount, dev);
        if (hipFuncSetAttribute((const void*)mega_fwd, hipFuncAttributeMaxDynamicSharedMemorySize, LDS_BYTES) != hipSuccess) { fprintf(stderr, "kernel_launch: hipFuncSetAttribute failed\n"); grid = -1; return; }
        if (hipOccupancyMaxActiveBlocksPerMultiprocessor(&per_cu, (const void*)mega_fwd, NTHR, LDS_BYTES) != hipSuccess || per_cu < 1) { fprintf(stderr, "kernel_launch: occupancy query says %d\n", per_cu); per_cu = 1; }
        (void)hipGetLastError();
        grid = cus * per_cu;
        if (grid > 256) grid = 256;
    }
    if (grid < 0) return;
    Args a{};
    for (int i = 0; i < 24; ++i) a.in[i] = (const float*)d_in[i];
    a.out = (float*)d_out; a.ws = (unsigned char*)d_ws;
    if (hipMemsetAsync((char*)d_ws + WS_CTL, 0, CTL_ZERO_BYTES, stream) != hipSuccess) { fprintf(stderr, "kernel_launch: hipMemsetAsync failed\n"); return; }
#if MK_MULTI
    for (int p = 0; p < N_PHASES; ++p) { a.ph_lo = p; a.ph_hi = p + 1; hipLaunchKernelGGL(mega_fwd, dim3(grid), dim3(NTHR), LDS_BYTES, stream, a); }
#else
    a.ph_lo = 0; a.ph_hi = N_PHASES;
    void* args[] = {&a};
    hipError_t e = hipLaunchCooperativeKernel((const void*)mega_fwd, dim3(grid), dim3(NTHR), args, LDS_BYTES, stream);
    if (e != hipSuccess) fprintf(stderr, "kernel_launch: cooperative launch failed: %s (grid %d)\n", hipGetErrorString(e), grid);
#endif
}
```
